# Optimizing an MI355X kernel written in HIP

```python
import jax, jax.numpy as jnp
from jax import lax
import numpy as np

D_MODEL = 1024
BATCH = 32
SEQ = 2048
DEPTH = 1

PLE_DIM = 256
EPS = 1e-6
GMLP_WIDTH = 1024
GMLP_GROUPS = 4
GMLP_GROUP_DIM = GMLP_WIDTH // GMLP_GROUPS
GMLP_CHUNK = 128
HGRN_HEADS = 8
HGRN_KEY_DIM = 128
HGRN_VAL_DIM = 128
HGRN_FORGET_WIDTH = HGRN_HEADS * HGRN_KEY_DIM
HGRN_WIDTH = HGRN_HEADS * HGRN_VAL_DIM
HGRN_CHUNK = 32
COL_SIZES = (GMLP_WIDTH, GMLP_WIDTH, GMLP_WIDTH, HGRN_FORGET_WIDTH, HGRN_FORGET_WIDTH, HGRN_WIDTH, HGRN_WIDTH, D_MODEL, D_MODEL)
IN_COLS = sum(COL_SIZES)
SPLIT_POINTS = tuple(int(c) for c in np.cumsum(COL_SIZES)[:-1])

kernel_name = "hybrid_gmlp_hgrn2_gated_block"


def rms_norm(x, g):
    xf = x.astype(jnp.float32)
    y = xf * lax.rsqrt(jnp.mean(xf * xf, axis=-1, keepdims=True) + EPS)
    return (y * g.astype(jnp.float32)).astype(x.dtype)


def layer_norm(x, g, b):
    xf = x.astype(jnp.float32)
    mu = jnp.mean(xf, axis=-1, keepdims=True)
    xc = xf - mu
    y = xc * lax.rsqrt(jnp.mean(xc * xc, axis=-1, keepdims=True) + EPS)
    return (y * g.astype(jnp.float32) + b.astype(jnp.float32)).astype(x.dtype)


def gmlp_spatial_gating(u, v, ln_g, ln_b, w_s, b_s):
    bsz, t, _ = u.shape
    n = t // GMLP_CHUNK
    v = layer_norm(v, ln_g, ln_b)
    v = v.reshape(bsz, n, GMLP_CHUNK, GMLP_GROUPS, GMLP_GROUP_DIM)
    causal = jnp.tril(jnp.ones((GMLP_CHUNK, GMLP_CHUNK), dtype=bool))
    w = jnp.where(causal[None], w_s, jnp.zeros_like(w_s))
    v = jnp.einsum('gts,bnsgc->bntgc', w, v) + b_s.T[:, :, None]
    return u * v.reshape(bsz, t, GMLP_WIDTH)


def hgrn2_chunked(q, k, g, v):
    bsz, t = q.shape[:2]
    n = t // HGRN_CHUNK

    def to_chunks(a):
        return a.reshape(bsz, n, HGRN_CHUNK, HGRN_HEADS, a.shape[-1]).transpose(1, 0, 3, 2, 4)

    qc, kc, gc, vc = to_chunks(q), to_chunks(k), to_chunks(g), to_chunks(v)
    causal = jnp.tril(jnp.ones((HGRN_CHUNK, HGRN_CHUNK), dtype=bool))[:, :, None]

    def step(state, inp):
        qb, kb, gb, vb = inp
        cum = jnp.cumsum(gb, axis=2)
        o_inter = jnp.einsum('bhtd,bhdv->bhtv', qb * jnp.exp(cum), state)
        diff = cum[:, :, :, None, :] - cum[:, :, None, :, :]
        decay = jnp.exp(jnp.where(causal, diff, -jnp.inf))
        scores = jnp.einsum('bhtd,bhsd,bhtsd->bhts', qb, kb, decay)
        o = o_inter + jnp.einsum('bhts,bhsv->bhtv', scores, vb)
        last = cum[:, :, -1:, :]
        state = jnp.exp(last[:, :, 0, :])[..., None] * state + jnp.einsum('bhsd,bhsv->bhdv', kb * jnp.exp(last - cum), vb)
        return state, o

    s0 = jnp.zeros((bsz, HGRN_HEADS, HGRN_KEY_DIM, HGRN_VAL_DIM), jnp.float32)
    _, o = lax.scan(step, s0, (qc, kc, gc, vc))
    return o.transpose(1, 0, 3, 2, 4).reshape(bsz, t, HGRN_HEADS, HGRN_VAL_DIM)


def setup_inputs(seed: int = 0) -> dict:
    key = jax.random.key(seed)
    ks = jax.random.split(key, 20)
    f32 = jnp.float32

    def nrm(k, shape, scale):
        return jax.random.normal(k, shape, f32) * scale

    return {
        "x": nrm(ks[0], (BATCH, SEQ, D_MODEL), 1.0),
        "p": nrm(ks[1], (DEPTH, BATCH, SEQ, PLE_DIM), 1.0),
        "w_in": nrm(ks[2], (DEPTH, D_MODEL, IN_COLS), D_MODEL ** -0.5),
        "gmlp_ln_g": 1.0 + nrm(ks[3], (DEPTH, GMLP_WIDTH), 0.05),
        "gmlp_ln_b": nrm(ks[4], (DEPTH, GMLP_WIDTH), 0.02),
        "gmlp_w_s": nrm(ks[5], (DEPTH, GMLP_GROUPS, GMLP_CHUNK, GMLP_CHUNK), 0.5 * GMLP_CHUNK ** -0.5),
        "gmlp_b_s": 1.0 + nrm(ks[6], (DEPTH, GMLP_GROUPS, GMLP_CHUNK), 0.05),
        "hgrn_lb_logits": nrm(ks[7], (DEPTH + 1, HGRN_FORGET_WIDTH), 0.5),
        "hgrn_norm_g": 1.0 + nrm(ks[8], (DEPTH, HGRN_HEADS, HGRN_VAL_DIM), 0.05),
        "w_branch_a": nrm(ks[9], (DEPTH, GMLP_WIDTH, D_MODEL), GMLP_WIDTH ** -0.5),
        "w_branch_b": nrm(ks[10], (DEPTH, HGRN_WIDTH, D_MODEL), HGRN_WIDTH ** -0.5),
        "w_out": nrm(ks[11], (DEPTH, D_MODEL, D_MODEL), D_MODEL ** -0.5),
        "g_pre": 1.0 + nrm(ks[12], (DEPTH, D_MODEL), 0.05),
        "g_post": 1.0 + nrm(ks[13], (DEPTH, D_MODEL), 0.05),
        "w_ple": nrm(ks[14], (DEPTH, PLE_DIM, D_MODEL), PLE_DIM ** -0.5),
        "w_ple_gate": nrm(ks[15], (DEPTH, D_MODEL, D_MODEL), D_MODEL ** -0.5),
        "b_ple_gate": nrm(ks[16], (DEPTH, D_MODEL), 0.02),
        "g_ple": 1.0 + nrm(ks[17], (DEPTH, D_MODEL), 0.05),
    }


def reference(x, p, w_in, gmlp_ln_g, gmlp_ln_b, gmlp_w_s, gmlp_b_s, hgrn_lb_logits, hgrn_norm_g,
              w_branch_a, w_branch_b, w_out, g_pre, g_post, w_ple, w_ple_gate, b_ple_gate, g_ple):
    bsz, t, _ = x.shape
    lower_bounds = jnp.cumsum(jax.nn.softmax(hgrn_lb_logits.astype(jnp.float32), axis=0), axis=0)
    for i in range(DEPTH):
        h = rms_norm(x, g_pre[i])
        proj = h @ w_in[i]
        u, v, z_a, q, f, inp, z_b, a_a, a_b = jnp.split(proj, SPLIT_POINTS, axis=-1)

        y_a = gmlp_spatial_gating(jax.nn.gelu(u, approximate=False), jax.nn.gelu(v, approximate=False),
                                  gmlp_ln_g[i], gmlp_ln_b[i], gmlp_w_s[i], gmlp_b_s[i])
        y_a = (y_a * jax.nn.silu(z_a)) @ w_branch_a[i]

        lb = lower_bounds[i]
        forget = lb + (1.0 - lb) * jax.nn.sigmoid(f.astype(jnp.float32))
        k_in = (1.0 - forget).reshape(bsz, t, HGRN_HEADS, HGRN_KEY_DIM)
        log_f = jnp.log(forget).reshape(bsz, t, HGRN_HEADS, HGRN_KEY_DIM)
        q_h = (jax.nn.silu(q.astype(jnp.float32)) * (HGRN_KEY_DIM ** -0.5)).reshape(bsz, t, HGRN_HEADS, HGRN_KEY_DIM)
        v_h = inp.astype(jnp.float32).reshape(bsz, t, HGRN_HEADS, HGRN_VAL_DIM)
        o = hgrn2_chunked(q_h, k_in, log_f, v_h)
        o = rms_norm(o, hgrn_norm_g[i]).reshape(bsz, t, HGRN_WIDTH).astype(x.dtype)
        y_b = (o * jax.nn.silu(z_b)) @ w_branch_b[i]

        merged = jax.nn.sigmoid(a_a) * y_a + jax.nn.sigmoid(a_b) * y_b
        x = x + rms_norm(merged @ w_out[i], g_post[i])

        e = p[i].astype(x.dtype) @ w_ple[i]
        gate = jax.nn.sigmoid(x @ w_ple_gate[i] + b_ple_gate[i])
        x = x + rms_norm(e * gate, g_ple[i])
    return x
```

```cpp
#include <hip/hip_runtime.h>
#include <hip/hip_cooperative_groups.h>
#include <cstdio>
namespace cg = cooperative_groups;

#define DI __device__ __forceinline__
#define LAS __attribute__((address_space(3)))
typedef unsigned short bf16_t;
typedef short bf16x8 __attribute__((ext_vector_type(8)));
typedef short s16x4 __attribute__((ext_vector_type(4)));
typedef float f32x2 __attribute__((ext_vector_type(2)));
typedef float f32x4 __attribute__((ext_vector_type(4)));
typedef float f32x16 __attribute__((ext_vector_type(16)));
typedef unsigned u32x2 __attribute__((ext_vector_type(2)));
typedef unsigned u32x4 __attribute__((ext_vector_type(4)));
typedef __bf16 bf16v2 __attribute__((ext_vector_type(2)));

constexpr int D = 1024, BATCH = 32, SEQ = 2048, M_TOT = BATCH * SEQ, PLE = 256, NCOLS = 9216;
constexpr int NSLICE = 2, MS = M_TOT / NSLICE;
constexpr float EPS = 1e-6f;
constexpr int NTHREADS = 512;
constexpr int LDS_MISC = 152064;
constexpr int LDS_BYTES = LDS_MISC + 64;

constexpr size_t U = (size_t)M_TOT * D * 2;
constexpr size_t HU = U / NSLICE;
constexpr size_t WS_WIN = 0;
constexpr size_t WS_WA = WS_WIN + (size_t)NCOLS * D * 2;
constexpr size_t WS_WB = WS_WA + (size_t)D * D * 2;
constexpr size_t WS_WO = WS_WB + (size_t)D * D * 2;
constexpr size_t WS_WG = WS_WO + (size_t)D * D * 2;
constexpr size_t WS_WP = WS_WG + (size_t)D * D * 2;
constexpr size_t WS_LB = WS_WP + (size_t)D * PLE * 2;
constexpr size_t WS_SSQ1 = WS_LB + 4096;
constexpr size_t WS_SSQ2 = WS_SSQ1 + (size_t)M_TOT * 16 * 4;
constexpr size_t WS_PBF = WS_SSQ2 + (size_t)M_TOT * 16 * 4;
constexpr size_t WS_H = WS_PBF + (size_t)M_TOT * PLE * 2;
constexpr size_t WS_Q = WS_H + U;
constexpr size_t WS_LF = WS_Q + U;
constexpr size_t WS_INP = WS_LF + U;
constexpr size_t WS_ZB = WS_INP + U;
constexpr size_t WS_GB = WS_ZB + U;
constexpr size_t WS_GA = WS_GB + U;
constexpr size_t WS_BAR = WS_GA + HU;
constexpr size_t WS_CNT = WS_BAR + 16384;
constexpr size_t WS_CNT_BYTES = (size_t)2 * NSLICE * (MS / 256) * 64;
constexpr size_t WS_XS = WS_CNT + WS_CNT_BYTES;
constexpr size_t WS_LNP = WS_XS + (size_t)2 * MS * 4 * 4;
constexpr size_t WS_END = WS_LNP + (size_t)MS * 16 * 8;
DI constexpr size_t SL(int k) { return WS_Q + (size_t)k * HU; }

struct Params {
    const float* x; const float* p; const float* w_in; const float* ln_g; const float* ln_b; const float* w_s; const float* b_s;
    const float* lb_logits; const float* hnorm_g; const float* w_a; const float* w_b; const float* w_out; const float* g_pre;
    const float* g_post; const float* w_ple; const float* w_gate; const float* b_gate; const float* g_ple;
    float* out; unsigned char* ws;
};

DI unsigned pk2(float lo, float hi) { f32x2 v = {lo, hi}; bf16v2 b = __builtin_convertvector(v, bf16v2); return __builtin_bit_cast(unsigned, b); }
DI float bflo(unsigned w) { return __uint_as_float(w << 16); }
DI float bfhi(unsigned w) { return __uint_as_float(w & 0xffff0000u); }
DI float bf1(bf16_t b) { return __uint_as_float(((unsigned)b) << 16); }
DI float fexp(float x) { return __builtin_amdgcn_exp2f(x * 1.44269504089f); }
DI float frcp(float x) { return __builtin_amdgcn_rcpf(x); }
DI float sigm(float x) { return frcp(1.0f + fexp(-x)); }
DI float silu(float x) { return x * sigm(x); }
DI float flog(float x) { return __builtin_amdgcn_logf(x) * 0.69314718056f; }
DI float gelu1(float v) {
    const float av = __builtin_fabsf(v), d = av * 0.2316418882f + 1.0f, t = frcp(d);
    float q = t * 0.5307027145f + (-0.7265760135f); q = q * t + 0.7107068705f; q = q * t + (-0.142248368f); q = q * t + 0.127414796f; q = q * t;
    const float e = __builtin_amdgcn_exp2f((v * v) * (-0.72134752044f));
    const float m = v * (q * e), r = v - m;
    return v < 0.f ? m : r;
}
DI unsigned q8(float s) { return (unsigned)__builtin_fminf(__builtin_fmaxf(s * 255.0f + 0.5f, 1.0f), 255.0f); }
DI bf16x8 pack8(float a0, float a1, float a2, float a3, float a4, float a5, float a6, float a7) {
    u32x4 p; p.x = pk2(a0, a1); p.y = pk2(a2, a3); p.z = pk2(a4, a5); p.w = pk2(a6, a7); return __builtin_bit_cast(bf16x8, p);
}
#define MFMA32(a, b, c) __builtin_amdgcn_mfma_f32_32x32x16_bf16((a), (b), (c), 0, 0, 0)
DI int otid(int wv) { int l; asm volatile("v_mbcnt_lo_u32_b32 %0, -1, 0\n\tv_mbcnt_hi_u32_b32 %0, -1, %0" : "=v"(l)); return wv * 64 + l; }
DI f32x16 zero16() { f32x16 z; for (int i = 0; i < 16; ++i) z[i] = 0.f; return z; }

namespace pg {
constexpr int BM = 256, BK = 64, HALF = 128, HTB = HALF * BK * 2, NXCD = 8, WGM = 8;
DI int lds_byte(int r, int c) { const int st = (r >> 4) * 2 + (c >> 5), rr = r & 15, cc = c & 31, ob = rr * 64 + cc * 2; return st * 1024 + (ob ^ (((ob >> 9) & 1) << 5)); }
DI void stage_rc(int b, int& R, int& C) { const int st = b / 1024, sb = b % 1024, swz = sb ^ (((sb >> 9) & 1) << 5); R = (st >> 1) * 16 + swz / 64; C = (st & 1) * 32 + (swz % 64) / 2; }
DI int perm32(int rho) { const int n = rho >> 4, i = rho & 15; return 8 * (i >> 2) + 4 * n + (i & 3); }
struct Unit { int pm, pn, part; };

struct Order {
    int nM, nN, nwg, G, c, parts;
    DI void init(int M, int N, int G_, int c_, int parts_) { nM = M / BM; nN = N / BM; nwg = nM * nN; G = G_; c = c_; parts = parts_; }
    DI bool next(int i, Unit& u) const {
        const int ti = i / parts; u.part = i - ti * parts;
        const long L = (long)ti * G + c; if (L >= nwg) return false;
        int wgid = (int)L; { const int q = nwg / NXCD, r = nwg % NXCD, xcd = wgid % NXCD, off = wgid / NXCD; wgid = (xcd < r ? xcd * (q + 1) : r * (q + 1) + (xcd - r) * q) + off; }
        const int nig = WGM * nN, gid = wgid / nig, fm = gid * WGM, gsz = (nM - fm) < WGM ? (nM - fm) : WGM;
        u.pm = fm + ((wgid % nig) % gsz); u.pn = (wgid % nig) / gsz; return true;
    }
};

template <bool SWAP = false, class Src, class Epi>
DI void gemm_phase(const int wv, LAS unsigned char* lds, const int K, const Order& S, const Src& P, const Epi& E) {
    const int tid = otid(wv), wid = __builtin_amdgcn_readfirstlane(tid >> 6), lane = tid & 63, wr = wid >> 2, wc = wid & 3, fr = lane & 15, fq = lane >> 4;
    const int nt = K / BK;
    unsigned voffA[2], voffB[2];
#pragma unroll
    for (int i = 0; i < 2; ++i) { int R, C; stage_rc(tid * 16 + i * 8192, R, C); const int Rb = (R & ~31) + perm32(R & 31);
        voffA[i] = (unsigned)((SWAP ? Rb : R) * K + C) * 2u; voffB[i] = (unsigned)(Rb * K + C) * 2u; }
    const size_t kstep = (size_t)(BK * 2);
    const size_t hstep = (size_t)HALF * K * 2;
    const unsigned ldsw = (unsigned)wid * 1024u;
    const int aoff = lds_byte(wr * 64 + fr, fq * 8), boff = lds_byte(wc * 32 + fr, fq * 8);
#define PG_SA(b, h) (((b) * 2 + (h)) * HTB)
#define PG_SB(b, h) ((4 + (b) * 2 + (h)) * HTB)
#define PG_STAGE(bufoff, gbase, voff) do { _Pragma("unroll") for (int _i = 0; _i < 2; ++_i) \
        __builtin_amdgcn_global_load_lds((const unsigned*)((const char*)(gbase) + (voff)[_i]), (LAS unsigned*)(lds + (bufoff) + ldsw + _i * 8192), 16, 0, 0); } while (0)
#define PG_LDA(dst, b, h) do { _Pragma("unroll") for (int m = 0; m < 4; ++m) _Pragma("unroll") for (int k = 0; k < 2; ++k) dst[m][k] = *(const LAS bf16x8*)(lds + PG_SA(b, h) + aoff + m * 2048 + k * 1024); } while (0)
#define PG_LDB(dst, b, h) do { _Pragma("unroll") for (int n = 0; n < 2; ++n) _Pragma("unroll") for (int k = 0; k < 2; ++k) dst[n][k] = *(const LAS bf16x8*)(lds + PG_SB(b, h) + boff + n * 2048 + k * 1024); } while (0)
#define PG_MMA(ai, bj, At, Bt) do { __builtin_amdgcn_s_setprio(1); _Pragma("unroll") for (int m = 0; m < 4; ++m) _Pragma("unroll") for (int n = 0; n < 2; ++n) _Pragma("unroll") for (int k = 0; k < 2; ++k) \
        acc[ai][bj][m][n] = SWAP ? __builtin_amdgcn_mfma_f32_16x16x32_bf16(At[m][k], Bt[n][k], acc[ai][bj][m][n], 0, 0, 0) : __builtin_amdgcn_mfma_f32_16x16x32_bf16(Bt[n][k], At[m][k], acc[ai][bj][m][n], 0, 0, 0); __builtin_amdgcn_s_setprio(0); } while (0)
#define PG_WAIT_V(n) asm volatile("s_waitcnt vmcnt(" #n ")" ::: "memory")
#define PG_WAIT_L(n) asm volatile("s_waitcnt lgkmcnt(" #n ")" ::: "memory")
#define PG_BAR __builtin_amdgcn_s_barrier()
#define PG_SCHED __builtin_amdgcn_sched_barrier(0)
    Unit cur, nxt; int ui = 0;
    if (!S.next(0, cur)) return;
    f32x4 acc[2][2][4][2];
#pragma unroll
    for (int a = 0; a < 2; ++a)
#pragma unroll
        for (int b = 0; b < 2; ++b)
#pragma unroll
            for (int m = 0; m < 4; ++m)
#pragma unroll
                for (int n = 0; n < 2; ++n) acc[a][b][m][n] = (f32x4){0.f, 0.f, 0.f, 0.f};
    bf16x8 At[4][2], B0[2][2], B1[2][2];
    const char* cA = P.a(cur); const char* cB = P.b(cur); size_t cBh = P.bh(cur);
    PG_STAGE(PG_SB(0, 0), cB, voffB); PG_STAGE(PG_SA(0, 0), cA, voffA); PG_STAGE(PG_SB(0, 1), cB + cBh, voffB); PG_STAGE(PG_SA(0, 1), cA + hstep, voffA);
    if (wr == 1) PG_BAR;
    PG_WAIT_V(4); PG_BAR;
    PG_STAGE(PG_SB(1, 0), cB + kstep, voffB); PG_STAGE(PG_SA(1, 0), cA + kstep, voffA); PG_STAGE(PG_SB(1, 1), cB + cBh + kstep, voffB);
    PG_WAIT_V(6); PG_BAR;
    for (;;) {
        const bool has_next = S.next(ui + 1, nxt);
        const char* nA = has_next ? P.a(nxt) : cA; const char* nB = has_next ? P.b(nxt) : cB; const size_t nBh = has_next ? P.bh(nxt) : cBh;
        for (int t = 0; t < nt; t += 2) {
            const bool last = (t == nt - 2);
            const char* a1 = cA + (size_t)(t + 1) * kstep;
            const char* a2 = last ? nA : cA + (size_t)(t + 2) * kstep; const char* b2 = last ? nB : cB + (size_t)(t + 2) * kstep;
            const char* a3 = a2 + kstep; const char* b3 = b2 + kstep; const size_t bh2 = last ? nBh : cBh;
            PG_LDB(B0, 0, 0); PG_SCHED; PG_LDA(At, 0, 0); PG_STAGE(PG_SA(1, 1), a1 + hstep, voffA);
            PG_WAIT_L(8); PG_BAR; PG_WAIT_L(0); PG_MMA(0, 0, At, B0); PG_BAR; PG_SCHED;
            PG_LDB(B1, 0, 1); PG_STAGE(PG_SB(0, 0), b2, voffB);
            PG_BAR; PG_WAIT_L(0); PG_MMA(0, 1, At, B1); PG_BAR;
            PG_LDA(At, 0, 1); PG_STAGE(PG_SA(0, 0), a2, voffA);
            PG_BAR; PG_WAIT_L(0); PG_MMA(1, 0, At, B0); PG_BAR; PG_SCHED;
            PG_STAGE(PG_SB(0, 1), b2 + bh2, voffB);
            PG_WAIT_V(6); PG_BAR; PG_MMA(1, 1, At, B1); PG_BAR;
            PG_LDB(B0, 1, 0); PG_SCHED; PG_LDA(At, 1, 0); PG_STAGE(PG_SA(0, 1), a2 + hstep, voffA);
            PG_WAIT_L(8); PG_BAR; PG_WAIT_L(0); PG_MMA(0, 0, At, B0); PG_BAR; PG_SCHED;
            PG_LDB(B1, 1, 1); PG_STAGE(PG_SB(1, 0), b3, voffB);
            PG_BAR; PG_WAIT_L(0); PG_MMA(0, 1, At, B1); PG_BAR;
            PG_LDA(At, 1, 1); PG_STAGE(PG_SA(1, 0), a3, voffA);
            PG_BAR; PG_WAIT_L(0); PG_MMA(1, 0, At, B0); PG_BAR; PG_SCHED;
            PG_STAGE(PG_SB(1, 1), b3 + bh2, voffB);
            PG_WAIT_V(6); PG_BAR; PG_MMA(1, 1, At, B1); PG_BAR;
        }
        const bool keep = E(acc, cur, wr, wc, fr, fq);
        if (!has_next) break;
        if (!keep) {
#pragma unroll
            for (int a = 0; a < 2; ++a)
#pragma unroll
                for (int b = 0; b < 2; ++b)
#pragma unroll
                    for (int m = 0; m < 4; ++m)
#pragma unroll
                        for (int n = 0; n < 2; ++n) acc[a][b][m][n] = (f32x4){0.f, 0.f, 0.f, 0.f};
        }
        cur = nxt; cA = nA; cB = nB; cBh = nBh; ++ui;
    }
    PG_WAIT_V(0);
    if (wr == 0) PG_BAR;
    PG_BAR;
#undef PG_SA
#undef PG_SB
#undef PG_STAGE
#undef PG_LDA
#undef PG_LDB
#undef PG_MMA
#undef PG_WAIT_V
#undef PG_WAIT_L
#undef PG_BAR
#undef PG_SCHED
}
}
using pg::Unit;
typedef f32x4 AccT[2][2][4][2];

struct SrcIn {
    const char* A; const char* Bt; int split_pn, jump_rows;
    DI const char* a(const Unit& u) const { return A + (size_t)u.pm * 256 * D * 2; }
    DI const char* b(const Unit& u) const { const int row = (u.pn < split_pn) ? u.pn * 256 : jump_rows + (u.pn - split_pn) * 256; return Bt + (size_t)row * D * 2; }
    DI size_t bh(const Unit&) const { return (size_t)128 * D * 2; }
};
struct SrcOther {
    const char* A; const char* Bt;
    DI const char* a(const Unit& u) const { return A + (size_t)u.pm * 256 * D * 2; }
    DI const char* b(const Unit& u) const { const int row = (u.pn < 8) ? u.pn * 128 : (u.pn < 12) ? D + (u.pn - 8) * 256 : 7 * D + (u.pn - 12) * 128; return Bt + (size_t)row * D * 2; }
    DI size_t bh(const Unit& u) const { return (u.pn < 8) ? (size_t)2 * D * D * 2 : (u.pn < 12) ? (size_t)128 * D * 2 : (size_t)D * D * 2; }
};
struct SrcPlain { const char* A; const char* Bt; int K;
    DI const char* a(const Unit& u) const { return A + (size_t)u.pm * 256 * K * 2; }
    DI const char* b(const Unit& u) const { return Bt + (size_t)u.pn * 256 * K * 2; }
    DI size_t bh(const Unit&) const { return (size_t)128 * K * 2; }
};
struct SrcMerge { const char* A0; const char* A1; const char* B0; const char* B1;
    DI const char* a(const Unit& u) const { return (u.part ? A1 : A0) + (size_t)u.pm * 256 * D * 2; }
    DI const char* b(const Unit& u) const { return (u.part ? B1 : B0) + (size_t)u.pn * 256 * D * 2; }
    DI size_t bh(const Unit&) const { return (size_t)128 * D * 2; }
};

template <int MODE  >
struct EpiAct {
    bf16_t* base; size_t seg_stride; const float* lb; int plain;
    DI bool operator()(AccT& acc, const Unit& u, int wr, int wc, int fr, int fq) const {
        const int seg = u.pn >> 2;
        int act;
        if (MODE == 0) act = (seg == 0) ? 3 : (seg == 1) ? 4 : (seg == 2) ? 0 : 2;
        else act = (seg <= 1) ? 1 : (seg == 2) ? 2 : 5;
        if (plain) act = 0;
        bf16_t* ob = base + (size_t)seg * seg_stride;
        const int row0 = u.pm * 256 + wr * 64 + fr, col0 = (u.pn & 3) * 256 + wc * 32 + 8 * fq;
#pragma unroll
        for (int bj = 0; bj < 2; ++bj) {
            float oml[8];
            if (MODE == 0 && act == 4) {
                const f32x4 l0 = *(const f32x4*)(lb + col0 + bj * 128), l1 = *(const f32x4*)(lb + col0 + bj * 128 + 4);
#pragma unroll
                for (int j = 0; j < 4; ++j) { oml[j] = 1.0f - l0[j]; oml[4 + j] = 1.0f - l1[j]; }
            }
#pragma unroll
            for (int ai = 0; ai < 2; ++ai)
#pragma unroll
                for (int m = 0; m < 4; ++m) {
                    float v[8];
#pragma unroll
                    for (int j = 0; j < 4; ++j) { v[j] = acc[ai][bj][m][0][j]; v[4 + j] = acc[ai][bj][m][1][j]; }
                    if (act == 1) {
#pragma unroll
                        for (int j = 0; j < 8; ++j) v[j] = gelu1(v[j]);
                    } else if (act == 2) {
#pragma unroll
                        for (int j = 0; j < 8; ++j) v[j] = silu(v[j]);
                    } else if (act == 3) {
#pragma unroll
                        for (int j = 0; j < 8; ++j) v[j] = silu(v[j]) * 0.08838834764831845f;
                    } else if (act == 4) {
                        if (MODE == 0) {
#pragma unroll
                            for (int j = 0; j < 8; ++j) { const float kk = oml[j] * frcp(1.0f + fexp(v[j])); v[j] = flog(1.0f - kk); }
                        }
                    } else if (act == 5) {
#pragma unroll
                        for (int j = 0; j < 8; ++j) v[j] = sigm(v[j]);
                    }
                    u32x4 w; w.x = pk2(v[0], v[1]); w.y = pk2(v[2], v[3]); w.z = pk2(v[4], v[5]); w.w = pk2(v[6], v[7]);
                    *(u32x4*)(ob + (size_t)(row0 + ai * 128 + m * 16) * D + col0 + bj * 128) = w;
                }
        }
        return false;
    }
};


struct EpiScanT {
    bf16_t* base; size_t seg_stride; const float* lb;
    DI bool operator()(AccT& acc, const Unit& u, int wr, int wc, int fr, int fq) const {
        const int seg = u.pn >> 2;
        bf16_t* ob = base + (size_t)seg * seg_stride;
        const int c32 = 8 * (fr >> 2) + (fr & 3);
        float omls[4] = {0.f, 0.f, 0.f, 0.f};
        if (seg == 1) {
#pragma unroll
            for (int q = 0; q < 4; ++q) omls[q] = 1.0f - lb[(u.pn & 3) * 256 + (q >> 1) * 128 + wc * 32 + c32 + 4 * (q & 1)];
        }
#pragma unroll
        for (int bj = 0; bj < 2; ++bj)
#pragma unroll
            for (int n = 0; n < 2; ++n) {
                const int C = (u.pn & 3) * 256 + bj * 128 + wc * 32 + c32 + 4 * n;
                const int hd = C >> 7, ch = C & 127;
                const float oml = omls[bj * 2 + n];
#pragma unroll
                for (int ai = 0; ai < 2; ++ai)
#pragma unroll
                    for (int m2 = 0; m2 < 2; ++m2) {
                        const int row = u.pm * 256 + ai * 128 + wr * 64 + m2 * 32;
                        const int b = row >> 11, nc = (row & 2047) >> 5;
                        float v[8];
#pragma unroll
                        for (int j = 0; j < 4; ++j) { v[j] = acc[ai][bj][2 * m2][n][j]; v[4 + j] = acc[ai][bj][2 * m2 + 1][n][j]; }
                        if (seg == 0) {
#pragma unroll
                            for (int j = 0; j < 8; ++j) v[j] = silu(v[j]) * 0.08838834764831845f;
                        } else if (seg == 1) {
#pragma unroll
                            for (int j = 0; j < 8; ++j) { const float kk = oml * frcp(1.0f + fexp(v[j])); v[j] = flog(1.0f - kk); }
                        }
                        u32x4 w; w.x = pk2(v[0], v[1]); w.y = pk2(v[2], v[3]); w.z = pk2(v[4], v[5]); w.w = pk2(v[6], v[7]);
                        *(u32x4*)(ob + ((size_t)((b * 8 + hd) * 64 + nc)) * 4096 + fq * 1024 + ch * 8) = w;
                    }
            }
        return false;
    }
};
struct EpiSilu {
    bf16_t* outp;
    DI bool operator()(AccT& acc, const Unit& u, int wr, int wc, int fr, int fq) const {
        const int row0 = u.pm * 256 + wr * 64 + fr, col0 = u.pn * 256 + wc * 32 + 8 * fq;
#pragma unroll
        for (int ai = 0; ai < 2; ++ai)
#pragma unroll
            for (int m = 0; m < 4; ++m)
#pragma unroll
                for (int bj = 0; bj < 2; ++bj) {
                    float v[8];
#pragma unroll
                    for (int j = 0; j < 4; ++j) { v[j] = silu(acc[ai][bj][m][0][j]); v[4 + j] = silu(acc[ai][bj][m][1][j]); }
                    u32x4 w; w.x = pk2(v[0], v[1]); w.y = pk2(v[2], v[3]); w.z = pk2(v[4], v[5]); w.w = pk2(v[6], v[7]);
                    *(u32x4*)(outp + (size_t)(row0 + ai * 128 + m * 16) * D + col0 + bj * 128) = w;
                }
        return false;
    }
};
struct EpiOther {
    bf16_t* guz; bf16_t* gv; bf16_t* sg; f32x2* lnp;
    DI bool operator()(AccT& acc, const Unit& u, int wr, int wc, int fr, int fq) const {
        const int row0 = u.pm * 256 + wr * 64 + fr;
        if (u.pn < 8) {
            const int col0 = u.pn * 128 + wc * 32 + 8 * fq;
#pragma unroll
            for (int ai = 0; ai < 2; ++ai)
#pragma unroll
                for (int m = 0; m < 4; ++m) {
                    float v[8];
#pragma unroll
                    for (int j = 0; j < 4; ++j) { v[j] = gelu1(acc[ai][0][m][0][j]) * silu(acc[ai][1][m][0][j]); v[4 + j] = gelu1(acc[ai][0][m][1][j]) * silu(acc[ai][1][m][1][j]); }
                    u32x4 w; w.x = pk2(v[0], v[1]); w.y = pk2(v[2], v[3]); w.z = pk2(v[4], v[5]); w.w = pk2(v[6], v[7]);
                    *(u32x4*)(guz + (size_t)(row0 + ai * 128 + m * 16) * D + col0) = w;
                }
        } else if (u.pn < 12) {
            const int col0 = (u.pn - 8) * 256 + wc * 32 + 8 * fq;
#pragma unroll
            for (int ai = 0; ai < 2; ++ai)
#pragma unroll
                for (int m = 0; m < 4; ++m) {
                    const int row = row0 + ai * 128 + m * 16;
                    float s1 = 0.f, s2 = 0.f;
#pragma unroll
                    for (int bj = 0; bj < 2; ++bj) {
                        float v[8];
#pragma unroll
                        for (int j = 0; j < 4; ++j) { v[j] = gelu1(acc[ai][bj][m][0][j]); v[4 + j] = gelu1(acc[ai][bj][m][1][j]); }
#pragma unroll
                        for (int j = 0; j < 8; ++j) { s1 += v[j]; s2 += v[j] * v[j]; }
                        u32x4 w; w.x = pk2(v[0], v[1]); w.y = pk2(v[2], v[3]); w.z = pk2(v[4], v[5]); w.w = pk2(v[6], v[7]);
                        *(u32x4*)(gv + (size_t)row * D + col0 + bj * 128) = w;
                    }
                    s1 += __shfl_xor(s1, 16); s1 += __shfl_xor(s1, 32); s2 += __shfl_xor(s2, 16); s2 += __shfl_xor(s2, 32);
                    if (fq == 0) lnp[(size_t)row * 16 + (u.pn - 8) * 4 + wc] = (f32x2){s1, s2};
                }
        } else {
            const int col0 = (u.pn - 12) * 128 + wc * 32 + 8 * fq;
#pragma unroll
            for (int ai = 0; ai < 2; ++ai)
#pragma unroll
                for (int m = 0; m < 4; ++m) {
                    unsigned q[8];
#pragma unroll
                    for (int j = 0; j < 4; ++j) {
                        const float a0 = sigm(acc[ai][0][m][0][j]), a1 = sigm(acc[ai][0][m][1][j]), b0 = sigm(acc[ai][1][m][0][j]), b1 = sigm(acc[ai][1][m][1][j]);
                        q[j] = q8(a0) | (q8(b0) << 8); q[4 + j] = q8(a1) | (q8(b1) << 8);
                    }
                    u32x4 w; w.x = q[0] | (q[1] << 16); w.y = q[2] | (q[3] << 16); w.z = q[4] | (q[5] << 16); w.w = q[6] | (q[7] << 16);
                    *(u32x4*)(sg + (size_t)(row0 + ai * 128 + m * 16) * D + col0) = w;
                }
        }
        return false;
    }
};
struct EpiMerge {
    const bf16_t* sg; bf16_t* outp;
    DI bool operator()(AccT& acc, const Unit& u, int wr, int wc, int fr, int fq) const {
        const int row0 = u.pm * 256 + wr * 64 + fr, col0 = u.pn * 256 + wc * 32 + 8 * fq;
        if (u.part == 0) {
#pragma unroll
            for (int g = 0; g < 4; ++g) {
                const int ai = g >> 1, bj = g & 1;
                u32x4 gg[4];
#pragma unroll
                for (int m = 0; m < 4; ++m) gg[m] = *(const u32x4*)(sg + (size_t)(row0 + ai * 128 + m * 16) * D + col0 + bj * 128);
#pragma unroll
                for (int m = 0; m < 4; ++m) {
                    const unsigned w4[4] = {gg[m].x, gg[m].y, gg[m].z, gg[m].w};
#pragma unroll
                    for (int j = 0; j < 4; ++j) {
                        const float ra = (float)(w4[j] & 0xffu) * frcp((float)((w4[j] >> 8) & 0xffu)), rb = (float)((w4[j] >> 16) & 0xffu) * frcp((float)(w4[j] >> 24));
                        const int c0 = 2 * j, c1 = 2 * j + 1;
                        acc[ai][bj][m][c0 >> 2][c0 & 3] *= ra; acc[ai][bj][m][c1 >> 2][c1 & 3] *= rb;
                    }
                }
            }
            return true;
        }
        u32x4 cur[4], nxt[4];
#pragma unroll
        for (int m = 0; m < 4; ++m) cur[m] = *(const u32x4*)(sg + (size_t)(row0 + m * 16) * D + col0);
#pragma unroll
        for (int g = 0; g < 4; ++g) {
            const int ai = g >> 1, bj = g & 1;
            if (g < 3) { const int ai2 = (g + 1) >> 1, bj2 = (g + 1) & 1;
#pragma unroll
                for (int m = 0; m < 4; ++m) nxt[m] = *(const u32x4*)(sg + (size_t)(row0 + ai2 * 128 + m * 16) * D + col0 + bj2 * 128); }
#pragma unroll
            for (int m = 0; m < 4; ++m) {
                const unsigned w4[4] = {cur[m].x, cur[m].y, cur[m].z, cur[m].w};
                float v[8];
#pragma unroll
                for (int j = 0; j < 4; ++j) {
                    const int c0 = 2 * j, c1 = 2 * j + 1;
                    v[c0] = acc[ai][bj][m][c0 >> 2][c0 & 3] * ((float)((w4[j] >> 8) & 0xffu) * (1.0f / 255.0f));
                    v[c1] = acc[ai][bj][m][c1 >> 2][c1 & 3] * ((float)(w4[j] >> 24) * (1.0f / 255.0f));
                }
                u32x4 w; w.x = pk2(v[0], v[1]); w.y = pk2(v[2], v[3]); w.z = pk2(v[4], v[5]); w.w = pk2(v[6], v[7]);
                *(u32x4*)(outp + (size_t)(row0 + ai * 128 + m * 16) * D + col0 + bj * 128) = w;
            }
#pragma unroll
            for (int m = 0; m < 4; ++m) cur[m] = nxt[m];
        }
        return false;
    }
};
template <int MODE>
struct EpiRow {
    bf16_t* outp; float* ssq; const bf16_t* e; const float* bias;
    DI bool operator()(AccT& acc, const Unit& u, int wr, int wc, int fr, int fq) const {
        const int row0 = u.pm * 256 + wr * 64 + fr, col0 = u.pn * 256 + wc * 32 + 8 * fq;
        float bs[2][8];
        if (MODE == 2) {
#pragma unroll
            for (int bj = 0; bj < 2; ++bj) { const f32x4 b0 = *(const f32x4*)(bias + col0 + bj * 128), b1 = *(const f32x4*)(bias + col0 + bj * 128 + 4);
#pragma unroll
                for (int j = 0; j < 4; ++j) { bs[bj][j] = b0[j]; bs[bj][4 + j] = b1[j]; } }
        }
        u32x4 cur[4], nxt[4];
        if (MODE == 2) {
#pragma unroll
            for (int q = 0; q < 4; ++q) cur[q] = *(const u32x4*)(e + (size_t)(row0 + (q >> 1) * 16) * D + col0 + (q & 1) * 128);
        }
#pragma unroll
        for (int g = 0; g < 4; ++g) {
            const int ai = g >> 1, mp = g & 1;
            if (MODE == 2 && g < 3) { const int ai2 = (g + 1) >> 1, mp2 = (g + 1) & 1;
#pragma unroll
                for (int q = 0; q < 4; ++q) nxt[q] = *(const u32x4*)(e + (size_t)(row0 + ai2 * 128 + (mp2 * 2 + (q >> 1)) * 16) * D + col0 + (q & 1) * 128); }
#pragma unroll
            for (int mm = 0; mm < 2; ++mm) {
                const int m = mp * 2 + mm;
                const int row = row0 + ai * 128 + m * 16;
                float s = 0.f;
#pragma unroll
                for (int bj = 0; bj < 2; ++bj) {
                    const size_t off = (size_t)row * D + col0 + bj * 128;
                    float v[8];
#pragma unroll
                    for (int j = 0; j < 4; ++j) { v[j] = acc[ai][bj][m][0][j]; v[4 + j] = acc[ai][bj][m][1][j]; }
                    if (MODE == 2) {
                        const u32x4 ev = cur[mm * 2 + bj];
                        const float ef[8] = {bflo(ev.x), bfhi(ev.x), bflo(ev.y), bfhi(ev.y), bflo(ev.z), bfhi(ev.z), bflo(ev.w), bfhi(ev.w)};
#pragma unroll
                        for (int j = 0; j < 8; ++j) v[j] = ef[j] * sigm(v[j] + bs[bj][j]);
                    }
                    if (MODE != 1) {
#pragma unroll
                        for (int j = 0; j < 8; ++j) s += v[j] * v[j];
                    }
                    u32x4 w; w.x = pk2(v[0], v[1]); w.y = pk2(v[2], v[3]); w.z = pk2(v[4], v[5]); w.w = pk2(v[6], v[7]);
                    *(u32x4*)(outp + off) = w;
                }
                if (MODE != 1) {
                    s += __shfl_xor(s, 16); s += __shfl_xor(s, 32);
                    if (fq == 0) ssq[(size_t)row * 16 + u.pn * 4 + wc] = s;
                }
            }
            if (MODE == 2) {
#pragma unroll
                for (int q = 0; q < 4; ++q) cur[q] = nxt[q];
            }
        }
        return false;
    }
};


DI void rowstat_exchange(const float (&part)[2][4], LAS unsigned char* lds, float* xs, unsigned* cnt, const pg::Unit& u, int wr, int wc, int fr, int fq) {
    LAS float* P = (LAS float*)(lds + 131072); LAS float* S = P + 1024;
    const int wid = wr * 4 + wc, lane = fq * 16 + fr, tid = wid * 64 + lane;
#pragma unroll
    for (int ai = 0; ai < 2; ++ai)
#pragma unroll
        for (int m = 0; m < 4; ++m) {
            float sq = part[ai][m];
            sq += __shfl_xor(sq, 16); sq += __shfl_xor(sq, 32);
            if (fq == 0) P[(ai * 128 + wr * 64 + m * 16 + fr) * 4 + wc] = sq;
        }
    asm volatile("s_waitcnt lgkmcnt(0)" ::: "memory");
    if (wr == 0) __builtin_amdgcn_s_barrier();
    __builtin_amdgcn_s_barrier(); asm volatile("" ::: "memory");
    if (tid < 256) {
        const f32x4 p4 = *(const LAS f32x4*)(P + tid * 4);
        __hip_atomic_store(xs + ((size_t)u.pm * 256 + tid) * 4 + u.pn, (p4[0] + p4[1]) + (p4[2] + p4[3]), __ATOMIC_RELAXED, __HIP_MEMORY_SCOPE_AGENT);
    }
    asm volatile("s_waitcnt vmcnt(0)" ::: "memory");
    if (tid < 256 && lane == 0) __hip_atomic_fetch_add(cnt + u.pm * 16, 1u, __ATOMIC_RELAXED, __HIP_MEMORY_SCOPE_AGENT);
    if (wid == 0) {
        unsigned spins = 0;
        while ((unsigned)__builtin_amdgcn_readfirstlane(__hip_atomic_load(cnt + u.pm * 16, __ATOMIC_RELAXED, __HIP_MEMORY_SCOPE_AGENT)) < 16u) {
            __builtin_amdgcn_s_sleep(2);
            if (++spins > (1u << 22)) break;
        }
        __builtin_amdgcn_fence(__ATOMIC_ACQUIRE, "agent");
        asm volatile("s_waitcnt vmcnt(0)" ::: "memory");
    }
    asm volatile("" ::: "memory"); __builtin_amdgcn_s_barrier(); asm volatile("" ::: "memory");
    if (tid < 256) {
        const unsigned long long* sp = (const unsigned long long*)(xs + ((size_t)u.pm * 256 + tid) * 4);
        const unsigned long long a = __hip_atomic_load(sp, __ATOMIC_RELAXED, __HIP_MEMORY_SCOPE_AGENT), b = __hip_atomic_load(sp + 1, __ATOMIC_RELAXED, __HIP_MEMORY_SCOPE_AGENT);
        const float tot = (__uint_as_float((unsigned)a) + __uint_as_float((unsigned)(a >> 32))) + (__uint_as_float((unsigned)b) + __uint_as_float((unsigned)(b >> 32)));
        S[tid] = __builtin_amdgcn_rsqf(tot * (1.0f / D) + EPS);
    }
    asm volatile("s_waitcnt lgkmcnt(0)" ::: "memory");
    __builtin_amdgcn_s_barrier(); asm volatile("" ::: "memory");
}
DI void rowstat_end(int wr) { if (wr == 1) __builtin_amdgcn_s_barrier(); }

struct EpiX1 {
    const float* x; const float* g_post; bf16_t* x1b; float* xs; unsigned* cnt; LAS unsigned char* lds; size_t row_off;
    DI bool operator()(AccT& acc, const Unit& u, int wr, int wc, int fr, int fq) const {
        const int row0 = u.pm * 256 + wr * 64 + fr, col0 = u.pn * 256 + wc * 32 + 8 * fq;
        float part[2][4];
#pragma unroll
        for (int ai = 0; ai < 2; ++ai)
#pragma unroll
            for (int m = 0; m < 4; ++m) {
                float sq = 0.f;
#pragma unroll
                for (int bj = 0; bj < 2; ++bj)
#pragma unroll
                    for (int n = 0; n < 2; ++n)
#pragma unroll
                        for (int j = 0; j < 4; ++j) sq += acc[ai][bj][m][n][j] * acc[ai][bj][m][n][j];
                part[ai][m] = sq;
            }
        float gp[2][8];
#pragma unroll
        for (int bj = 0; bj < 2; ++bj) { const f32x4 g0 = *(const f32x4*)(g_post + col0 + bj * 128), g1 = *(const f32x4*)(g_post + col0 + bj * 128 + 4);
#pragma unroll
            for (int j = 0; j < 4; ++j) { gp[bj][j] = g0[j]; gp[bj][4 + j] = g1[j]; } }
        f32x4 cur[4], nxt[4];
#pragma unroll
        for (int q = 0; q < 4; ++q) cur[q] = *(const f32x4*)(x + (row_off + row0) * D + col0 + (q >> 1) * 128 + (q & 1) * 4);
        rowstat_exchange(part, lds, xs, cnt, u, wr, wc, fr, fq);
        const LAS float* S = (const LAS float*)(lds + 131072 + 4096);
#pragma unroll
        for (int g = 0; g < 8; ++g) {
            const int ai = g >> 2, m = g & 3;
            if (g < 7) { const int ai2 = (g + 1) >> 2, m2 = (g + 1) & 3;
#pragma unroll
                for (int q = 0; q < 4; ++q) nxt[q] = *(const f32x4*)(x + (row_off + row0 + ai2 * 128 + m2 * 16) * D + col0 + (q >> 1) * 128 + (q & 1) * 4); }
            const float rs = S[ai * 128 + wr * 64 + m * 16 + fr];
#pragma unroll
            for (int bj = 0; bj < 2; ++bj) {
                float v[8];
#pragma unroll
                for (int j = 0; j < 4; ++j) { v[j] = cur[bj * 2][j] + acc[ai][bj][m][0][j] * rs * gp[bj][j]; v[4 + j] = cur[bj * 2 + 1][j] + acc[ai][bj][m][1][j] * rs * gp[bj][4 + j]; }
                u32x4 w; w.x = pk2(v[0], v[1]); w.y = pk2(v[2], v[3]); w.z = pk2(v[4], v[5]); w.w = pk2(v[6], v[7]);
                *(u32x4*)(x1b + (size_t)(row0 + ai * 128 + m * 16) * D + col0 + bj * 128) = w;
            }
#pragma unroll
            for (int q = 0; q < 4; ++q) cur[q] = nxt[q];
        }
        rowstat_end(wr);
        return false;
    }
};

struct EpiOut {
    const bf16_t* e; const float* bias; const bf16_t* x1b; const float* g_ple; float* out; float* xs; unsigned* cnt; LAS unsigned char* lds; size_t row_off;
    DI bool operator()(AccT& acc, const Unit& u, int wr, int wc, int fr, int fq) const {
        { int l; asm volatile("v_mbcnt_lo_u32_b32 %0, -1, 0\n\tv_mbcnt_hi_u32_b32 %0, -1, %0" : "=v"(l)); fr = l & 15; fq = l >> 4; }
        const int row0 = u.pm * 256 + wr * 64 + fr, col0 = u.pn * 256 + wc * 32 + 8 * fq;
        const unsigned off0 = (unsigned)(row0 * D + col0);
        const char* eb = (const char*)e; const char* xb = (const char*)x1b; char* ob = (char*)(out + row_off * D);
        float part[2][4];
        {
            u32x4 ec = *(const u32x4*)(eb + (size_t)(off0 * 2u)), en = ec;
#pragma unroll
            for (int g = 0; g < 16; ++g) {
                const int ai = g >> 3, m = (g >> 1) & 3, bj = g & 1;
                if (g < 15) { const int ai2 = (g + 1) >> 3, m2 = ((g + 1) >> 1) & 3, bj2 = (g + 1) & 1;
                    en = *(const u32x4*)(eb + (size_t)((off0 + (ai2 * 128 + m2 * 16) * D + bj2 * 128) * 2u)); }
                const f32x4 b0 = *(const f32x4*)(bias + col0 + bj * 128), b1 = *(const f32x4*)(bias + col0 + bj * 128 + 4);
                const float ef[8] = {bflo(ec.x), bfhi(ec.x), bflo(ec.y), bfhi(ec.y), bflo(ec.z), bfhi(ec.z), bflo(ec.w), bfhi(ec.w)};
                float sq = 0.f;
#pragma unroll
                for (int j = 0; j < 4; ++j) {
                    const float v0 = ef[j] * sigm(acc[ai][bj][m][0][j] + b0[j]), v1 = ef[4 + j] * sigm(acc[ai][bj][m][1][j] + b1[j]);
                    acc[ai][bj][m][0][j] = v0; acc[ai][bj][m][1][j] = v1; sq += v0 * v0 + v1 * v1;
                }
                if (bj == 0) part[ai][m] = sq; else part[ai][m] += sq;
                ec = en;
            }
        }
        rowstat_exchange(part, lds, xs, cnt, u, wr, wc, fr, fq);
        const LAS float* S = (const LAS float*)(lds + 131072 + 4096);
        {
            f32x4 gq[2][2];
#pragma unroll
            for (int bj = 0; bj < 2; ++bj) { gq[bj][0] = *(const f32x4*)(g_ple + col0 + bj * 128); gq[bj][1] = *(const f32x4*)(g_ple + col0 + bj * 128 + 4); }
            u32x4 xc = *(const u32x4*)(xb + (size_t)(off0 * 2u)), xn = xc;
#pragma unroll
            for (int g = 0; g < 16; ++g) {
                const int ai = g >> 3, m = (g >> 1) & 3, bj = g & 1;
                if (g < 15) { const int ai2 = (g + 1) >> 3, m2 = ((g + 1) >> 1) & 3, bj2 = (g + 1) & 1;
                    xn = *(const u32x4*)(xb + (size_t)((off0 + (ai2 * 128 + m2 * 16) * D + bj2 * 128) * 2u)); }
                const float rs = S[ai * 128 + wr * 64 + m * 16 + fr];
                const f32x4 g0 = gq[bj][0], g1 = gq[bj][1];
                const float xf[8] = {bflo(xc.x), bfhi(xc.x), bflo(xc.y), bfhi(xc.y), bflo(xc.z), bfhi(xc.z), bflo(xc.w), bfhi(xc.w)};
                f32x4 o0, o1;
#pragma unroll
                for (int j = 0; j < 4; ++j) { o0[j] = xf[j] + acc[ai][bj][m][0][j] * rs * g0[j]; o1[j] = xf[4 + j] + acc[ai][bj][m][1][j] * rs * g1[j]; }
                char* op = ob + (size_t)((off0 + (ai * 128 + m * 16) * D + bj * 128) * 4u);
                *(f32x4*)op = o0; *(f32x4*)(op + 16) = o1;
                xc = xn;
            }
        }
        rowstat_end(wr);
        return false;
    }
};

struct TileRef { const float* src; bf16_t* dst; int K, N, k0, n0; };
DI bool tile_ref(const Params& p, int idx, TileRef& r) {
    constexpr int T0 = (D / 64) * (NCOLS / 64), T1 = (D / 64) * (D / 64), TP = (PLE / 64) * (D / 64);
    if (idx >= T0 + 4 * T1 + TP) return false;
    unsigned char* ws = p.ws;
    int t = idx; r.K = D; r.N = D;
    if (idx < T0) { r.src = p.w_in; r.dst = (bf16_t*)(ws + WS_WIN); r.N = NCOLS; }
    else if (idx < T0 + T1) { r.src = p.w_a; r.dst = (bf16_t*)(ws + WS_WA); t = idx - T0; }
    else if (idx < T0 + 2 * T1) { r.src = p.w_b; r.dst = (bf16_t*)(ws + WS_WB); t = idx - T0 - T1; }
    else if (idx < T0 + 3 * T1) { r.src = p.w_out; r.dst = (bf16_t*)(ws + WS_WO); t = idx - T0 - 2 * T1; }
    else if (idx < T0 + 4 * T1) { r.src = p.w_gate; r.dst = (bf16_t*)(ws + WS_WG); t = idx - T0 - 3 * T1; }
    else { r.src = p.w_ple; r.dst = (bf16_t*)(ws + WS_WP); r.K = PLE; t = idx - T0 - 4 * T1; }
    const int nn = r.N / 64; r.k0 = (t / nn) * 64; r.n0 = (t % nn) * 64;
    return true;
}
DI void transpose_all(const int wv, const Params& p, LAS float* tiles) {
    const int tid = otid(wv), ty = tid >> 4, tx = tid & 15, n = tid >> 3, kq = tid & 7;
    int idx = blockIdx.x, buf = 0;
    TileRef cur, nxt; bool have = tile_ref(p, idx, cur);
    f32x4 v0, v1;
    if (have) { v0 = *(const f32x4*)(cur.src + (size_t)(cur.k0 + ty) * cur.N + cur.n0 + tx * 4); v1 = *(const f32x4*)(cur.src + (size_t)(cur.k0 + ty + 32) * cur.N + cur.n0 + tx * 4); }
    while (have) {
        LAS float* tile = tiles + buf * (64 * 65);
        tile[ty * 65 + tx * 4 + 0] = v0[0]; tile[ty * 65 + tx * 4 + 1] = v0[1]; tile[ty * 65 + tx * 4 + 2] = v0[2]; tile[ty * 65 + tx * 4 + 3] = v0[3];
        tile[(ty + 32) * 65 + tx * 4 + 0] = v1[0]; tile[(ty + 32) * 65 + tx * 4 + 1] = v1[1]; tile[(ty + 32) * 65 + tx * 4 + 2] = v1[2]; tile[(ty + 32) * 65 + tx * 4 + 3] = v1[3];
        idx += gridDim.x;
        const bool hn = tile_ref(p, idx, nxt);
        if (hn) { v0 = *(const f32x4*)(nxt.src + (size_t)(nxt.k0 + ty) * nxt.N + nxt.n0 + tx * 4); v1 = *(const f32x4*)(nxt.src + (size_t)(nxt.k0 + ty + 32) * nxt.N + nxt.n0 + tx * 4); }
        __syncthreads();
        float t[8];
#pragma unroll
        for (int j = 0; j < 8; ++j) t[j] = tile[(kq * 8 + j) * 65 + n];
        u32x4 w; w.x = pk2(t[0], t[1]); w.y = pk2(t[2], t[3]); w.z = pk2(t[4], t[5]); w.w = pk2(t[6], t[7]);
        *(u32x4*)(cur.dst + (size_t)(cur.n0 + n) * cur.K + cur.k0 + kq * 8) = w;
        buf ^= 1; cur = nxt; have = hn;
    }
    __syncthreads();
}
DI void phase0(const int wv, const Params& p, LAS unsigned char* lds) {
    unsigned char* ws = p.ws;
    transpose_all(wv, p, (LAS float*)lds);
    const int tid = otid(wv), lane = tid & 63, wid = tid >> 6;
    if (blockIdx.x == 0) {
        float* lb = (float*)(ws + WS_LB);
        for (int c = tid; c < D; c += NTHREADS) lb[c] = frcp(1.0f + fexp(p.lb_logits[D + c] - p.lb_logits[c]));
    }
    {
        bf16_t* h = (bf16_t*)(ws + WS_H);
        f32x4 g[4];
#pragma unroll
        for (int i = 0; i < 4; ++i) g[i] = *(const f32x4*)(p.g_pre + lane * 4 + 256 * i);
        for (int row = (blockIdx.x * 8 + wid) * 2; row < M_TOT; row += gridDim.x * 16) {
            f32x4 v[2][4]; float rs[2];
#pragma unroll
            for (int r2 = 0; r2 < 2; ++r2) {
                const float* xr = p.x + (size_t)(row + r2) * D;
#pragma unroll
                for (int i = 0; i < 4; ++i) v[r2][i] = *(const f32x4*)(xr + lane * 4 + 256 * i);
            }
#pragma unroll
            for (int r2 = 0; r2 < 2; ++r2) {
                float ss = 0.f;
#pragma unroll
                for (int i = 0; i < 4; ++i) ss += v[r2][i][0] * v[r2][i][0] + v[r2][i][1] * v[r2][i][1] + v[r2][i][2] * v[r2][i][2] + v[r2][i][3] * v[r2][i][3];
#pragma unroll
                for (int o = 32; o >= 1; o >>= 1) ss += __shfl_xor(ss, o);
                rs[r2] = __builtin_amdgcn_rsqf(ss * (1.0f / D) + EPS);
            }
#pragma unroll
            for (int r2 = 0; r2 < 2; ++r2)
#pragma unroll
                for (int i = 0; i < 4; ++i) { u32x2 w; w.x = pk2(v[r2][i][0] * rs[r2] * g[i][0], v[r2][i][1] * rs[r2] * g[i][1]); w.y = pk2(v[r2][i][2] * rs[r2] * g[i][2], v[r2][i][3] * rs[r2] * g[i][3]);
                    *(u32x2*)(h + (size_t)(row + r2) * D + lane * 4 + 256 * i) = w; }
        }
    }
    {
        bf16_t* pb = (bf16_t*)(ws + WS_PBF);
        const size_t n8 = (size_t)M_TOT * PLE / 8;
        for (size_t i = (size_t)blockIdx.x * NTHREADS + tid; i < n8; i += (size_t)gridDim.x * NTHREADS) {
            const f32x4 a = *(const f32x4*)(p.p + i * 8), b = *(const f32x4*)(p.p + i * 8 + 4);
            u32x4 w; w.x = pk2(a[0], a[1]); w.y = pk2(a[2], a[3]); w.z = pk2(b[0], b[1]); w.w = pk2(b[2], b[3]);
            *(u32x4*)(pb + i * 8) = w;
        }
    }
}

constexpr int HG_SET = 38400, HG_QN = 0, HG_KN = 8704, HG_KT = 17408, HG_VT = 27648, HG_DEC = 37888, HG_TOT = 2 * HG_SET, HG_OB = HG_TOT + 2 * 2048, HG_OBSZ = 2 * 32 * 132 * 4;
static_assert(HG_OB + 2 * HG_OBSZ <= LDS_MISC, "HGRN LDS overflow");
DI void hgrn_item(const int wv, LAS unsigned char* lds, const bf16_t* Q, const bf16_t* LF, const bf16_t* V, const bf16_t* ZB, bf16_t* GB, const float* norm_g, const size_t rowbase) {
    const int tid = otid(wv), wid = __builtin_amdgcn_readfirstlane(tid >> 6), lane = tid & 63, r = lane & 31, h = lane >> 5;
    constexpr int NCH = SEQ / 32;
    if (wid < 4) {
        const int vb = wid;
        f32x16 S[4];
#pragma unroll
        for (int i = 0; i < 4; ++i) S[i] = zero16();
        __syncthreads();
        for (int n = 0; n < NCH; ++n) {
            LAS unsigned char* ib = lds + (n & 1) * HG_SET;
            LAS float* Ob = (LAS float*)(lds + HG_OB + (n & 1) * HG_OBSZ);
            f32x16 P = zero16();
#pragma unroll
            for (int ks = 0; ks < 8; ++ks) {
                const bf16x8 a = *(const LAS bf16x8*)(ib + HG_KN + r * 272 + (16 * ks + 8 * h) * 2);
                const bf16x8 b = *(const LAS bf16x8*)(ib + HG_QN + r * 272 + (16 * ks + 8 * h) * 2);
                P = MFMA32(a, b, P);
            }
#pragma unroll
            for (int i = 0; i < 16; ++i) { const int s = (i & 3) + 8 * (i >> 2) + 4 * h; P[i] = (s <= r) ? P[i] : 0.f; }
            bf16x8 pbf[2], qfr[4][2], ktf[4][2], vtf[2];
#pragma unroll
            for (int k2 = 0; k2 < 2; ++k2) {
                const s16x4 lo = *(const LAS s16x4*)(ib + HG_VT + (32 * vb + r) * 80 + (16 * k2 + 4 * h) * 2);
                const s16x4 hi = *(const LAS s16x4*)(ib + HG_VT + (32 * vb + r) * 80 + (16 * k2 + 8 + 4 * h) * 2);
                pbf[k2] = __builtin_shufflevector(lo, hi, 0, 1, 2, 3, 4, 5, 6, 7);
                vtf[k2] = *(const LAS bf16x8*)(ib + HG_VT + (32 * vb + r) * 80 + (16 * k2 + 8 * h) * 2);
            }
#pragma unroll
            for (int db = 0; db < 4; ++db)
#pragma unroll
                for (int s2 = 0; s2 < 2; ++s2) {
                    const s16x4 lo = *(const LAS s16x4*)(ib + HG_QN + r * 272 + (32 * db + 16 * s2 + 4 * h) * 2);
                    const s16x4 hi = *(const LAS s16x4*)(ib + HG_QN + r * 272 + (32 * db + 16 * s2 + 8 + 4 * h) * 2);
                    qfr[db][s2] = __builtin_shufflevector(lo, hi, 0, 1, 2, 3, 4, 5, 6, 7);
                    ktf[db][s2] = *(const LAS bf16x8*)(ib + HG_KT + (32 * db + r) * 80 + (16 * s2 + 8 * h) * 2);
                }
            f32x16 o = zero16();
#pragma unroll
            for (int k2 = 0; k2 < 2; ++k2) {
                const bf16x8 pa = k2 ? pack8(P[8], P[9], P[10], P[11], P[12], P[13], P[14], P[15]) : pack8(P[0], P[1], P[2], P[3], P[4], P[5], P[6], P[7]);
                o = MFMA32(pa, pbf[k2], o);
            }
#pragma unroll
            for (int db = 0; db < 4; ++db) {
#pragma unroll
                for (int s2 = 0; s2 < 2; ++s2) {
                    const bf16x8 xs = s2 ? pack8(S[db][8], S[db][9], S[db][10], S[db][11], S[db][12], S[db][13], S[db][14], S[db][15]) : pack8(S[db][0], S[db][1], S[db][2], S[db][3], S[db][4], S[db][5], S[db][6], S[db][7]);
                    o = MFMA32(qfr[db][s2], xs, o);
                }
            }
#pragma unroll
            for (int db = 0; db < 4; ++db) {
#pragma unroll
                for (int ks = 0; ks < 2; ++ks) S[db] = MFMA32(ktf[db][ks], vtf[ks], S[db]);
#pragma unroll
                for (int gq = 0; gq < 4; ++gq) { const f32x4 dv = *(const LAS f32x4*)(ib + HG_DEC + (32 * db + 8 * gq + 4 * h) * 4);
#pragma unroll
                    for (int j = 0; j < 4; ++j) S[db][4 * gq + j] *= dv[j]; }
            }
#pragma unroll
            for (int i = 0; i < 16; ++i) { const int t = (i & 3) + 8 * (i >> 2) + 4 * h; Ob[t * 132 + 32 * vb + r] = o[i]; }
            __syncthreads();
        }
        __syncthreads();
        return;
    }
    const int d = (wid - 4) * 32 + (lane & 31), th = lane >> 5;
    const int tl = (wid - 4) * 64 + lane, et = tl >> 3, ev0 = (tl & 7) * 16;
    float ng[16];
#pragma unroll
    for (int j = 0; j < 16; ++j) ng[j] = norm_g[ev0 + j];
    u32x4 rq[4][2], rl[4][2], rv[4][2], rz[4][2];
#define HG_LOAD(n, K) do { _Pragma("unroll") for (int s_ = 0; s_ < 2; ++s_) { const size_t co = (size_t)(n) * 4096 + (2 * th + s_) * 1024 + d * 8; \
        rq[K][s_] = *(const u32x4*)(Q + co); rl[K][s_] = *(const u32x4*)(LF + co); rv[K][s_] = *(const u32x4*)(V + co); } } while (0)
#define HG_ELEM(n, K) do { \
        LAS unsigned char* ib_ = lds + ((n) & 1) * HG_SET; \
        const unsigned lw[8] = {rl[K][0].x, rl[K][0].y, rl[K][0].z, rl[K][0].w, rl[K][1].x, rl[K][1].y, rl[K][1].z, rl[K][1].w}; \
        const unsigned qw[8] = {rq[K][0].x, rq[K][0].y, rq[K][0].z, rq[K][0].w, rq[K][1].x, rq[K][1].y, rq[K][1].z, rq[K][1].w}; \
        float c[16]; float run = 0.f; \
        _Pragma("unroll") for (int j = 0; j < 8; ++j) { run += bflo(lw[j]); c[2 * j] = run; run += bfhi(lw[j]); c[2 * j + 1] = run; } \
        const float other = __shfl_xor(run, 32); \
        const float offc = th ? other : 0.f; \
        if (th == 0) ((LAS float*)(ib_ + HG_DEC))[d] = fexp(run + other); \
        float kvv[16]; float invp = fexp(fminf(-offc, 80.0f)); \
        _Pragma("unroll") for (int j = 0; j < 16; ++j) { \
            const float cum = offc + c[j]; \
            const float e = fexp(cum), inv = fexp(fminf(-cum, 80.0f)); \
            const float qf = (j & 1) ? bfhi(qw[j >> 1]) : bflo(qw[j >> 1]); \
            const float qv = qf * e; \
            const float kv = (1.0f - e * invp) * inv; \
            invp = inv; kvv[j] = kv; \
            ((LAS bf16_t*)(ib_ + HG_QN))[(16 * th + j) * 136 + d] = (bf16_t)(pk2(qv, 0.f) & 0xffffu); \
            ((LAS bf16_t*)(ib_ + HG_KN))[(16 * th + j) * 136 + d] = (bf16_t)(pk2(kv, 0.f) & 0xffffu); \
        } \
        *(LAS u32x4*)(ib_ + HG_KT + d * 80 + (16 * th) * 2) = (u32x4){pk2(kvv[0], kvv[1]), pk2(kvv[2], kvv[3]), pk2(kvv[4], kvv[5]), pk2(kvv[6], kvv[7])}; \
        *(LAS u32x4*)(ib_ + HG_KT + d * 80 + (16 * th + 8) * 2) = (u32x4){pk2(kvv[8], kvv[9]), pk2(kvv[10], kvv[11]), pk2(kvv[12], kvv[13]), pk2(kvv[14], kvv[15])}; \
        *(LAS u32x4*)(ib_ + HG_VT + d * 80 + (16 * th) * 2) = rv[K][0]; \
        *(LAS u32x4*)(ib_ + HG_VT + d * 80 + (16 * th + 8) * 2) = rv[K][1]; \
    } while (0)
#define HG_EPI(n, K) do { \
        const LAS unsigned char* ob_ = lds + HG_OB + ((n) & 1) * HG_OBSZ + (et * 132 + ev0) * 4; \
        float ov[16]; float ss = 0.f; \
        _Pragma("unroll") for (int q_ = 0; q_ < 4; ++q_) { const f32x4 a_ = *(const LAS f32x4*)(ob_ + q_ * 16); ov[4 * q_] = a_[0]; ov[4 * q_ + 1] = a_[1]; ov[4 * q_ + 2] = a_[2]; ov[4 * q_ + 3] = a_[3]; } \
        _Pragma("unroll") for (int j = 0; j < 16; ++j) ss += ov[j] * ov[j]; \
        ss += __shfl_xor(ss, 1); ss += __shfl_xor(ss, 2); ss += __shfl_xor(ss, 4); \
        const float rs = __builtin_amdgcn_rsqf(ss * (1.0f / 128.0f) + EPS); \
        const unsigned zw[8] = {rz[K][0].x, rz[K][0].y, rz[K][0].z, rz[K][0].w, rz[K][1].x, rz[K][1].y, rz[K][1].z, rz[K][1].w}; \
        unsigned wq[8]; \
        _Pragma("unroll") for (int j = 0; j < 8; ++j) wq[j] = pk2(ov[2 * j] * rs * ng[2 * j] * bflo(zw[j]), ov[2 * j + 1] * rs * ng[2 * j + 1] * bfhi(zw[j])); \
        bf16_t* gp_ = GB + rowbase + (size_t)((n) * 32 + et) * D + ev0; \
        *(u32x4*)gp_ = (u32x4){wq[0], wq[1], wq[2], wq[3]}; *(u32x4*)(gp_ + 8) = (u32x4){wq[4], wq[5], wq[6], wq[7]}; \
    } while (0)
#define HG_LOADZ(n, K) do { const bf16_t* zp_ = ZB + rowbase + (size_t)((n) * 32 + et) * D + ev0; rz[K][0] = *(const u32x4*)zp_; rz[K][1] = *(const u32x4*)(zp_ + 8); } while (0)
    HG_LOAD(0, 0); HG_LOAD(1, 1); HG_LOAD(2, 2); HG_LOAD(3, 3);
    HG_LOADZ(0, 0); HG_LOADZ(1, 1); HG_LOADZ(2, 2);
    HG_ELEM(0, 0);
    HG_LOAD(4, 0);
    __syncthreads();
#define HG_TRIP(n, K) do { \
        if ((n) + 1 < NCH) { HG_ELEM((n) + 1, ((K) + 1) & 3); if ((n) + 5 < NCH) HG_LOAD((n) + 5, ((K) + 1) & 3); } \
        if ((n) >= 1) HG_EPI((n) - 1, ((K) + 3) & 3); \
        if ((n) + 3 < NCH) HG_LOADZ((n) + 3, ((K) + 3) & 3); \
        __syncthreads(); \
    } while (0)
#pragma unroll 1
    for (int n = 0; n < NCH; n += 4) { HG_TRIP(n, 0); HG_TRIP(n + 1, 1); HG_TRIP(n + 2, 2); HG_TRIP(n + 3, 3); }
#undef HG_TRIP
    HG_EPI(NCH - 1, (NCH - 1) & 3);
    __syncthreads();
#undef HG_LOAD
#undef HG_ELEM
#undef HG_EPI
#undef HG_LOADZ
}

constexpr int GM_MU = 0, GM_RS = 512, GM_VT = 1024, GM_WS = 70656;
DI void gmlp_item(const int wv, LAS unsigned char* lds, const Params& p, const bf16_t* GUZ, const bf16_t* GV, const f32x2* LNP, bf16_t* GA, const int ch, const int g) {
    const int tid = otid(wv), wid = __builtin_amdgcn_readfirstlane(tid >> 6), lane = tid & 63, r = lane & 31, h = lane >> 5;
    LAS float* mu = (LAS float*)(lds + GM_MU); LAS float* rsd = (LAS float*)(lds + GM_RS);
    const size_t R0 = (size_t)ch * 128;
    if (tid < 128) {
        const f32x4* pp = (const f32x4*)(LNP + (R0 + tid) * 16);
        float s1 = 0.f, s2 = 0.f;
#pragma unroll
        for (int i = 0; i < 8; ++i) { const f32x4 q = pp[i]; s1 += q[0] + q[2]; s2 += q[1] + q[3]; }
        const float mean = s1 * (1.0f / D); const float var = fmaxf(s2 * (1.0f / D) - mean * mean, 0.f);
        mu[tid] = mean; rsd[tid] = __builtin_amdgcn_rsqf(var + EPS);
    }
    {
        const int t = tid >> 2, s0 = (tid & 3) * 32;
        const float* wp = p.w_s + ((size_t)g * 128 + t) * 128 + s0;
#pragma unroll
        for (int q = 0; q < 4; ++q) {
            const f32x4 a = *(const f32x4*)(wp + q * 8), b = *(const f32x4*)(wp + q * 8 + 4);
            float v[8] = {a[0], a[1], a[2], a[3], b[0], b[1], b[2], b[3]};
#pragma unroll
            for (int j = 0; j < 8; ++j) v[j] = (s0 + q * 8 + j <= t) ? v[j] : 0.f;
            u32x4 w; w.x = pk2(v[0], v[1]); w.y = pk2(v[2], v[3]); w.z = pk2(v[4], v[5]); w.w = pk2(v[6], v[7]);
            *(LAS u32x4*)(lds + GM_WS + t * 272 + (s0 + q * 8) * 2) = w;
        }
    }
    __syncthreads();
    for (int it = 0; it < 8; ++it) {
        const int idx = it * NTHREADS + tid, s = idx & 127, c8 = idx >> 7;
        const int cg0 = g * 256 + c8 * 8;
        const u32x4 a = *(const u32x4*)(GV + (R0 + s) * D + cg0);
        const f32x4 g0 = *(const f32x4*)(p.ln_g + cg0), g1 = *(const f32x4*)(p.ln_g + cg0 + 4), b0 = *(const f32x4*)(p.ln_b + cg0), b1 = *(const f32x4*)(p.ln_b + cg0 + 4);
        const float f[8] = {bflo(a.x), bfhi(a.x), bflo(a.y), bfhi(a.y), bflo(a.z), bfhi(a.z), bflo(a.w), bfhi(a.w)};
        const float gg[8] = {g0[0], g0[1], g0[2], g0[3], g1[0], g1[1], g1[2], g1[3]};
        const float bb[8] = {b0[0], b0[1], b0[2], b0[3], b1[0], b1[1], b1[2], b1[3]};
        const float m = mu[s], rs = rsd[s];
#pragma unroll
        for (int j = 0; j < 8; ++j) {
            const float y = (f[j] - m) * rs * gg[j] + bb[j];
            *(LAS bf16_t*)(lds + GM_VT + (c8 * 8 + j) * 272 + s * 2) = (bf16_t)(pk2(y, 0.f) & 0xffffu);
        }
    }
    __syncthreads();
    f32x16 acc[4];
#pragma unroll
    for (int tb = 0; tb < 4; ++tb) acc[tb] = zero16();
#pragma unroll
    for (int ks = 0; ks < 8; ++ks) {
        const bf16x8 a = *(const LAS bf16x8*)(lds + GM_VT + (32 * wid + r) * 272 + (16 * ks + 8 * h) * 2);
#pragma unroll
        for (int tb = 0; tb < 4; ++tb) {
            if (ks <= 2 * tb + 1) {
                const bf16x8 b = *(const LAS bf16x8*)(lds + GM_WS + (32 * tb + r) * 272 + (16 * ks + 8 * h) * 2);
                acc[tb] = MFMA32(a, b, acc[tb]);
            }
        }
    }
    __syncthreads();
#pragma unroll
    for (int tb = 0; tb < 4; ++tb) {
        const int t = 32 * tb + r;
        const float bsv = p.b_s[g * 128 + t];
#pragma unroll
        for (int gq = 0; gq < 4; ++gq) {
            u32x2 w; w.x = pk2(acc[tb][4 * gq] + bsv, acc[tb][4 * gq + 1] + bsv); w.y = pk2(acc[tb][4 * gq + 2] + bsv, acc[tb][4 * gq + 3] + bsv);
            *(LAS u32x2*)(lds + GM_VT + t * 528 + (32 * wid + 8 * gq + 4 * h) * 2) = w;
        }
    }
    __syncthreads();
    {
        u32x4 uu[8];
#pragma unroll
        for (int it = 0; it < 8; ++it) { const int idx = it * NTHREADS + tid, t = idx >> 5, c8 = idx & 31; uu[it] = *(const u32x4*)(GUZ + (R0 + t) * D + g * 256 + c8 * 8); }
#pragma unroll
        for (int it = 0; it < 8; ++it) {
            const int idx = it * NTHREADS + tid, t = idx >> 5, c8 = idx & 31;
            const u32x4 oo = *(const LAS u32x4*)(lds + GM_VT + t * 528 + c8 * 16);
            u32x4 w;
            w.x = pk2(bflo(uu[it].x) * bflo(oo.x), bfhi(uu[it].x) * bfhi(oo.x));
            w.y = pk2(bflo(uu[it].y) * bflo(oo.y), bfhi(uu[it].y) * bfhi(oo.y));
            w.z = pk2(bflo(uu[it].z) * bflo(oo.z), bfhi(uu[it].z) * bfhi(oo.z));
            w.w = pk2(bflo(uu[it].w) * bflo(oo.w), bfhi(uu[it].w) * bfhi(oo.w));
            *(u32x4*)(GA + (R0 + t) * D + g * 256 + c8 * 8) = w;
        }
    }
    __syncthreads();
}

DI float row_rs(const float* ssq, size_t grow, int lane) {
    float s = ssq[grow * 16 + (lane & 15)];
    s += __shfl_xor(s, 1); s += __shfl_xor(s, 2); s += __shfl_xor(s, 4); s += __shfl_xor(s, 8);
    return __builtin_amdgcn_rsqf(s * (1.0f / D) + EPS);
}
DI void x1_rows(const int wv, const Params& p, const int slice, const bf16_t* T, const float* ssq1, bf16_t* X1B) {
    const int tid = otid(wv), lane = tid & 63, wid = tid >> 6;
    f32x4 g[4];
#pragma unroll
    for (int i = 0; i < 2; ++i) { g[2 * i] = *(const f32x4*)(p.g_post + lane * 8 + 512 * i); g[2 * i + 1] = *(const f32x4*)(p.g_post + lane * 8 + 512 * i + 4); }
    for (int rr = (blockIdx.x * 8 + wid) * 2; rr < MS; rr += gridDim.x * 16) {
        f32x4 xv[2][4]; u32x4 tv[2][2]; float rs[2];
#pragma unroll
        for (int r2 = 0; r2 < 2; ++r2) {
            const size_t grow = (size_t)slice * MS + rr + r2;
            rs[r2] = row_rs(ssq1, grow, lane);
#pragma unroll
            for (int i = 0; i < 2; ++i) { const int c = lane * 8 + 512 * i;
                xv[r2][2 * i] = *(const f32x4*)(p.x + grow * D + c); xv[r2][2 * i + 1] = *(const f32x4*)(p.x + grow * D + c + 4);
                tv[r2][i] = *(const u32x4*)(T + (size_t)(rr + r2) * D + c); }
        }
#pragma unroll
        for (int r2 = 0; r2 < 2; ++r2)
#pragma unroll
            for (int i = 0; i < 2; ++i) {
                const int c = lane * 8 + 512 * i; const f32x4 x0 = xv[r2][2 * i], x1 = xv[r2][2 * i + 1], g0 = g[2 * i], g1 = g[2 * i + 1]; const u32x4 t4 = tv[r2][i]; const float r = rs[r2];
                u32x4 w;
                w.x = pk2(x0[0] + bflo(t4.x) * r * g0[0], x0[1] + bfhi(t4.x) * r * g0[1]);
                w.y = pk2(x0[2] + bflo(t4.y) * r * g0[2], x0[3] + bfhi(t4.y) * r * g0[3]);
                w.z = pk2(x1[0] + bflo(t4.z) * r * g1[0], x1[1] + bfhi(t4.z) * r * g1[1]);
                w.w = pk2(x1[2] + bflo(t4.w) * r * g1[2], x1[3] + bfhi(t4.w) * r * g1[3]);
                *(u32x4*)(X1B + (size_t)(rr + r2) * D + c) = w;
            }
    }
}
DI void final_rows(const int wv, const Params& p, const int slice, const bf16_t* X1B, const bf16_t* EG, const float* ssq2) {
    const int tid = otid(wv), lane = tid & 63, wid = tid >> 6;
    f32x4 q[4];
#pragma unroll
    for (int i = 0; i < 2; ++i) { q[2 * i] = *(const f32x4*)(p.g_ple + lane * 8 + 512 * i); q[2 * i + 1] = *(const f32x4*)(p.g_ple + lane * 8 + 512 * i + 4); }
    for (int rr = (blockIdx.x * 8 + wid) * 4; rr < MS; rr += gridDim.x * 32) {
        u32x4 xv[4][2], ev[4][2]; float rs2[4];
#pragma unroll
        for (int r2 = 0; r2 < 4; ++r2) {
            const size_t grow = (size_t)slice * MS + rr + r2;
            rs2[r2] = row_rs(ssq2, grow, lane);
#pragma unroll
            for (int i = 0; i < 2; ++i) { const int c = lane * 8 + 512 * i;
                xv[r2][i] = *(const u32x4*)(X1B + (size_t)(rr + r2) * D + c); ev[r2][i] = *(const u32x4*)(EG + (size_t)(rr + r2) * D + c); }
        }
#pragma unroll
        for (int r2 = 0; r2 < 4; ++r2)
#pragma unroll
            for (int i = 0; i < 2; ++i) {
                const int c = lane * 8 + 512 * i; const size_t grow = (size_t)slice * MS + rr + r2;
                const f32x4 q0 = q[2 * i], q1 = q[2 * i + 1]; const u32x4 x4 = xv[r2][i], e4 = ev[r2][i]; const float r2s = rs2[r2];
                f32x4 o0, o1;
                o0[0] = bflo(x4.x) + bflo(e4.x) * r2s * q0[0]; o0[1] = bfhi(x4.x) + bfhi(e4.x) * r2s * q0[1];
                o0[2] = bflo(x4.y) + bflo(e4.y) * r2s * q0[2]; o0[3] = bfhi(x4.y) + bfhi(e4.y) * r2s * q0[3];
                o1[0] = bflo(x4.z) + bflo(e4.z) * r2s * q1[0]; o1[1] = bfhi(x4.z) + bfhi(e4.z) * r2s * q1[1];
                o1[2] = bflo(x4.w) + bflo(e4.w) * r2s * q1[2]; o1[3] = bfhi(x4.w) + bfhi(e4.w) * r2s * q1[3];
                *(f32x4*)(p.out + grow * D + c) = o0; *(f32x4*)(p.out + grow * D + c + 4) = o1;
            }
    }
}

#define XB_TMO      128
#define XB_XCNT(j)  (256  + 64 * (j))
#define XB_XSUB(j)  (1280 + 64 * (j))
#define XB_XGEN(j)  (2304 + 64 * (j))
#define XB_TOP      3328
#define XB_TOPGEN   3392
#define XCD_BAR_WORDS 3456
#define XB_SPIN_CAP (1u << 18)
DI unsigned xb_ld(unsigned* p)              { return __hip_atomic_load(p, __ATOMIC_RELAXED, __HIP_MEMORY_SCOPE_AGENT); }
DI unsigned xb_add(unsigned* p, unsigned v) { return __hip_atomic_fetch_add(p, v, __ATOMIC_RELAXED, __HIP_MEMORY_SCOPE_AGENT); }
DI unsigned xb_xcc_id() { return (unsigned)__builtin_amdgcn_s_getreg((3 << 11) | 20) & 0xFu; }
#define XB_SPIN(cond, bar) do { unsigned _sp = 0; while (cond) { __builtin_amdgcn_s_sleep(1); \
    if ((++_sp & 255u) == 0u) { if (xb_ld(&(bar)[XB_TMO])) break; if (_sp > XB_SPIN_CAP) { atomicAdd(&(bar)[XB_TMO], 1u); break; } } } } while (0)
struct XcdBarrier { unsigned* bar; unsigned x; volatile LAS unsigned* st; int wv; };
DI XcdBarrier xcd_barrier_post(unsigned* bar, volatile LAS unsigned* st, int wv) {
    XcdBarrier b; b.bar = bar; b.x = xb_xcc_id(); b.st = st; b.wv = wv;
    if (otid(wv) == 0) (void)xb_add(&bar[XB_XCNT(b.x)], 1u);
    return b;
}
DI void xcd_barrier_complete(unsigned* bar, unsigned x, unsigned& nloc, unsigned& nx) {
    const unsigned G = gridDim.x * gridDim.y * gridDim.z;
    unsigned sum, cnt, mine, sp = 0u;
    for (;;) {
        sum = 0u; cnt = 0u; mine = 0u;
#pragma unroll
        for (unsigned j = 0; j < 16; ++j) { const unsigned c = xb_ld(&bar[XB_XCNT(j)]); sum += c; cnt += (c > 0u) ? 1u : 0u; mine = (j == x) ? c : mine; }
        if (sum == G) break;
        __builtin_amdgcn_s_sleep(1);
        if ((++sp & 255u) == 0u) { if (xb_ld(&bar[XB_TMO])) break; if (sp > XB_SPIN_CAP) { atomicAdd(&bar[XB_TMO], 1u); break; } }
    }
    nloc = mine > 0u ? mine : 1u; nx = cnt > 0u ? cnt : 1u;
}
DI void xcd_barrier(const XcdBarrier& b) {
    asm volatile("s_waitcnt vmcnt(0)" ::: "memory");
    __syncthreads();
    if (otid(b.wv) == 0) {
        unsigned* bar = b.bar;
        __builtin_amdgcn_s_waitcnt(0);
        unsigned nloc = b.st[0], nx = b.st[1];
        if (nloc == 0u) { xcd_barrier_complete(bar, b.x, nloc, nx); b.st[0] = nloc; b.st[1] = nx; }
        const unsigned old = xb_add(&bar[XB_XSUB(b.x)], 1u);
        const unsigned gen = old / nloc;
        if (old + 1u == (gen + 1u) * nloc) {
            __builtin_amdgcn_fence(__ATOMIC_RELEASE, "agent");
            asm volatile("s_waitcnt vmcnt(0)" ::: "memory");
            const unsigned og = xb_add(&bar[XB_TOP], 1u);
            const unsigned tg = og / nx;
            if (og + 1u == (tg + 1u) * nx) xb_add(&bar[XB_TOPGEN], 1u);
            else XB_SPIN(xb_ld(&bar[XB_TOPGEN]) == tg, bar);
            __builtin_amdgcn_fence(__ATOMIC_ACQUIRE, "agent");
            xb_add(&bar[XB_XGEN(b.x)], 1u);
            asm volatile("s_waitcnt vmcnt(0)" ::: "memory");
        } else {
            XB_SPIN(xb_ld(&bar[XB_XGEN(b.x)]) == gen, bar);
            __builtin_amdgcn_fence(__ATOMIC_ACQUIRE, "agent");
            asm volatile("s_waitcnt vmcnt(0)" ::: "memory");
        }
    }
    __syncthreads();
}

#ifndef REP_P1
#define REP_P1 1
#endif
#ifndef REP_HG
#define REP_HG 1
#endif
#ifndef REP_GM
#define REP_GM 1
#endif
#ifndef REP_SYNC
#define REP_SYNC 1
#endif
#define GSYNC() do { _Pragma("unroll 1") for (int _r = 0; _r < REP_SYNC; ++_r) xcd_barrier(xbar); } while (0)
__global__ void __launch_bounds__(NTHREADS, 2) fwd_megakernel(Params p) {
    extern __shared__ __attribute__((aligned(16))) unsigned char lds_raw[];
    LAS unsigned char* lds = (LAS unsigned char*)lds_raw;
    cg::grid_group grid = cg::this_grid();
    unsigned char* ws = p.ws;
    const int G = gridDim.x, c = blockIdx.x;
    const int wv = __builtin_amdgcn_readfirstlane((int)threadIdx.x >> 6);
    if (threadIdx.x < 16) ((LAS unsigned*)(lds + LDS_MISC))[threadIdx.x] = 0u;
    __syncthreads();
    const XcdBarrier xbar = xcd_barrier_post((unsigned*)(ws + WS_BAR), (volatile LAS unsigned*)(lds + LDS_MISC), wv);

    phase0(wv, p, lds);
    if (gridDim.y == 0xFFFFu) grid.sync();
    GSYNC();
    {
        pg::Order S; S.init(M_TOT, 3 * D, G, c, 1);
        SrcIn P; P.A = (const char*)(ws + WS_H); P.Bt = (const char*)(ws + WS_WIN) + (size_t)3 * D * D * 2; P.split_pn = 1 << 30; P.jump_rows = 0;
        EpiScanT E; E.base = (bf16_t*)(ws + WS_Q); E.seg_stride = U / 2; E.lb = (const float*)(ws + WS_LB);
        pg::gemm_phase<true>(wv, lds, D, S, P, E);
    }
    {
        pg::Order S; S.init(M_TOT, D, G, c, 1);
        SrcIn P; P.A = (const char*)(ws + WS_H); P.Bt = (const char*)(ws + WS_WIN) + (size_t)6 * D * D * 2; P.split_pn = 1 << 30; P.jump_rows = 0;
        EpiSilu E; E.outp = (bf16_t*)(ws + WS_ZB);
        pg::gemm_phase(wv, lds, D, S, P, E);
    }
    GSYNC();
#pragma unroll 1
    for (int rep = 0; rep < REP_HG; ++rep)
    for (int it = c; it < BATCH * 8; it += G) {
        const int b = it >> 3, hd = it & 7;
        const size_t ib0 = (size_t)it * 64 * 4096;
        hgrn_item(wv, lds, (const bf16_t*)(ws + WS_Q) + ib0, (const bf16_t*)(ws + WS_LF) + ib0, (const bf16_t*)(ws + WS_INP) + ib0, (const bf16_t*)(ws + WS_ZB), (bf16_t*)(ws + WS_GB), p.hnorm_g + hd * 128, (size_t)b * SEQ * D + hd * 128);
    }
    GSYNC();
    for (int sl = 0; sl < NSLICE; ++sl) {
        bf16_t* GU = (bf16_t*)(ws + SL(0)); bf16_t* GV = (bf16_t*)(ws + SL(1)); bf16_t* SZA = (bf16_t*)(ws + SL(2));
        bf16_t* SGA = (bf16_t*)(ws + SL(3)); bf16_t* SGB = (bf16_t*)(ws + SL(4)); bf16_t* EE = (bf16_t*)(ws + SL(5));
        bf16_t* MRG = GV; bf16_t* TT = SZA; bf16_t* X1B = GU; bf16_t* EG = SGB; bf16_t* GA = (bf16_t*)(ws + WS_GA);
        {
            pg::Order S; S.init(MS, 5 * D, G, c, 1);
            SrcOther P; P.A = (const char*)(ws + WS_H) + (size_t)sl * HU; P.Bt = (const char*)(ws + WS_WIN);
            EpiOther E; E.guz = GU; E.gv = GV; E.sg = SGA; E.lnp = (f32x2*)(ws + WS_LNP);
            pg::gemm_phase(wv, lds, D, S, P, E);
        }
        GSYNC();
#pragma unroll 1
        for (int rep = 0; rep < REP_GM; ++rep)
        for (int it = c; it < (MS / 128) * 4; it += G) gmlp_item(wv, lds, p, GU, GV, (const f32x2*)(ws + WS_LNP), GA, it >> 2, it & 3);
        GSYNC();
        {
            pg::Order S; S.init(MS, D, G, c, 2);
            SrcMerge P; P.A0 = (const char*)GA; P.A1 = (const char*)(ws + WS_GB) + (size_t)sl * HU; P.B0 = (const char*)(ws + WS_WA); P.B1 = (const char*)(ws + WS_WB);
            EpiMerge E; E.sg = SGA; E.outp = MRG;
            pg::gemm_phase(wv, lds, D, S, P, E);
        }
        GSYNC();
        {
            pg::Order S; S.init(MS, D, G, c, 1);
            SrcPlain P; P.A = (const char*)MRG; P.Bt = (const char*)(ws + WS_WO); P.K = D;
            EpiX1 E; E.x = p.x; E.g_post = p.g_post; E.x1b = X1B; E.xs = (float*)(ws + WS_XS); E.cnt = (unsigned*)(ws + WS_CNT) + (size_t)(0 * NSLICE + sl) * (MS / 256) * 16; E.lds = lds; E.row_off = (size_t)sl * MS;
            pg::gemm_phase(wv, lds, D, S, P, E);
        }
        {
            pg::Order S; S.init(MS, D, G, c, 1);
            SrcPlain P; P.A = (const char*)(ws + WS_PBF) + (size_t)sl * MS * PLE * 2; P.Bt = (const char*)(ws + WS_WP); P.K = PLE;
            EpiRow<1> E; E.outp = EE; E.ssq = nullptr; E.e = nullptr; E.bias = nullptr;
            pg::gemm_phase(wv, lds, PLE, S, P, E);
        }
        GSYNC();
        {
            pg::Order S; S.init(MS, D, G, c, 1);
            SrcPlain P; P.A = (const char*)X1B; P.Bt = (const char*)(ws + WS_WG); P.K = D;
            EpiOut E; E.e = EE; E.bias = p.b_gate; E.x1b = X1B; E.g_ple = p.g_ple; E.out = p.out; E.xs = (float*)(ws + WS_XS) + (size_t)MS * 4;
            E.cnt = (unsigned*)(ws + WS_CNT) + (size_t)(1 * NSLICE + sl) * (MS / 256) * 16; E.lds = lds; E.row_off = (size_t)sl * MS;
            pg::gemm_phase(wv, lds, D, S, P, E);
        }
        if (sl + 1 < NSLICE) GSYNC();
    }
}

extern "C" void kernel_launch(void* const* d_in, const int* in_sizes, int n_in, void* d_out, int out_size, void* d_ws, size_t ws_size, hipStream_t stream) {
    static int grid_blocks = 0;
    if (grid_blocks == 0) {
        if (ws_size < WS_END) { fprintf(stderr, "kernel_launch: workspace too small: %zu < %zu\n", ws_size, (size_t)WS_END); grid_blocks = -1; return; }
        int dev = 0, cus = 0, per_cu = 0;
        hipGetDevice(&dev);
        hipDeviceGetAttribute(&cus, hipDeviceAttributeMultiprocessorCount, dev);
        hipFuncSetAttribute((const void*)fwd_megakernel, hipFuncAttributeMaxDynamicSharedMemorySize, LDS_BYTES);
        hipOccupancyMaxActiveBlocksPerMultiprocessor(&per_cu, (const void*)fwd_megakernel, NTHREADS, LDS_BYTES);
        if (per_cu < 1) { fprintf(stderr, "kernel_launch: occupancy query returned %d\n", per_cu); per_cu = 1; }
        (void)hipGetLastError();
        grid_blocks = cus * 1;
    }
    if (grid_blocks < 0) return;
    Params p{};
    p.x = (const float*)d_in[0]; p.p = (const float*)d_in[1]; p.w_in = (const float*)d_in[2]; p.ln_g = (const float*)d_in[3]; p.ln_b = (const float*)d_in[4];
    p.w_s = (const float*)d_in[5]; p.b_s = (const float*)d_in[6]; p.lb_logits = (const float*)d_in[7]; p.hnorm_g = (const float*)d_in[8];
    p.w_a = (const float*)d_in[9]; p.w_b = (const float*)d_in[10]; p.w_out = (const float*)d_in[11]; p.g_pre = (const float*)d_in[12]; p.g_post = (const float*)d_in[13];
    p.w_ple = (const float*)d_in[14]; p.w_gate = (const float*)d_in[15]; p.b_gate = (const float*)d_in[16]; p.g_ple = (const float*)d_in[17];
    p.out = (float*)d_out; p.ws = (unsigned char*)d_ws;
    if (hipMemsetAsync((char*)d_ws + WS_BAR, 0, 16384 + WS_CNT_BYTES, stream) != hipSuccess) { fprintf(stderr, "memset of barrier words failed\n"); return; }
    void* args[] = {&p};
    hipError_t e = hipLaunchCooperativeKernel((const void*)fwd_megakernel, dim3(grid_blocks), dim3(NTHREADS), args, LDS_BYTES, stream);
    if (e != hipSuccess) fprintf(stderr, "cooperative launch failed: %s (grid %d)\n", hipGetErrorString(e), grid_blocks);
}
```

```cpp
#include <hip/hip_runtime.h>
#include <hip/hip_cooperative_groups.h>
#include <cstdio>
namespace cg = cooperative_groups;

#define DI __device__ __forceinline__
#define LAS __attribute__((address_space(3)))
typedef unsigned short bf16_t;
typedef short bf16x8 __attribute__((ext_vector_type(8)));
typedef short s16x4 __attribute__((ext_vector_type(4)));
typedef float f32x2 __attribute__((ext_vector_type(2)));
typedef float f32x4 __attribute__((ext_vector_type(4)));
typedef float f32x16 __attribute__((ext_vector_type(16)));
typedef unsigned u32x2 __attribute__((ext_vector_type(2)));
typedef unsigned u32x4 __attribute__((ext_vector_type(4)));
typedef __bf16 bf16v2 __attribute__((ext_vector_type(2)));

constexpr int D = 1024, BATCH = 32, SEQ = 2048, M_TOT = BATCH * SEQ, PLE = 256, NCOLS = 9216;
constexpr int NSLICE = 2, MS = M_TOT / NSLICE;
constexpr float EPS = 1e-6f;
constexpr int NTHREADS = 512;
constexpr int LDS_MISC = 152064;
constexpr int LDS_BYTES = LDS_MISC + 64;

constexpr size_t U = (size_t)M_TOT * D * 2;
constexpr size_t HU = U / NSLICE;
constexpr size_t WS_WIN = 0;
constexpr size_t WS_WA = WS_WIN + (size_t)NCOLS * D * 2;
constexpr size_t WS_WB = WS_WA + (size_t)D * D * 2;
constexpr size_t WS_WO = WS_WB + (size_t)D * D * 2;
constexpr size_t WS_WG = WS_WO + (size_t)D * D * 2;
constexpr size_t WS_WP = WS_WG + (size_t)D * D * 2;
constexpr size_t WS_LB = WS_WP + (size_t)D * PLE * 2;
constexpr size_t WS_SSQ1 = WS_LB + 4096;
constexpr size_t WS_SSQ2 = WS_SSQ1 + (size_t)M_TOT * 16 * 4;
constexpr size_t WS_PBF = WS_SSQ2 + (size_t)M_TOT * 16 * 4;
constexpr size_t WS_H = WS_PBF + (size_t)M_TOT * PLE * 2;
constexpr size_t WS_Q = WS_H + U;
constexpr size_t WS_LF = WS_Q + U;
constexpr size_t WS_INP = WS_LF + U;
constexpr size_t WS_ZB = WS_INP + U;
constexpr size_t WS_GB = WS_ZB + U;
constexpr size_t WS_GA = WS_GB + U;
constexpr size_t WS_BAR = WS_GA + HU;
constexpr size_t WS_CNT = WS_BAR + 16384;
constexpr size_t WS_CNT_BYTES = (size_t)2 * NSLICE * (MS / 256) * 64;
constexpr size_t WS_XS = WS_CNT + WS_CNT_BYTES;
constexpr size_t WS_LNP = WS_XS + (size_t)2 * MS * 4 * 4;
constexpr size_t WS_END = WS_LNP + (size_t)MS * 16 * 8;
DI constexpr size_t SL(int k) { return WS_Q + (size_t)k * HU; }

struct Params {
    const float* x; const float* p; const float* w_in; const float* ln_g; const float* ln_b; const float* w_s; const float* b_s;
    const float* lb_logits; const float* hnorm_g; const float* w_a; const float* w_b; const float* w_out; const float* g_pre;
    const float* g_post; const float* w_ple; const float* w_gate; const float* b_gate; const float* g_ple;
    float* out; unsigned char* ws;
};

DI unsigned pk2(float lo, float hi) { f32x2 v = {lo, hi}; bf16v2 b = __builtin_convertvector(v, bf16v2); return __builtin_bit_cast(unsigned, b); }
DI float bflo(unsigned w) { return __uint_as_float(w << 16); }
DI float bfhi(unsigned w) { return __uint_as_float(w & 0xffff0000u); }
DI float bf1(bf16_t b) { return __uint_as_float(((unsigned)b) << 16); }
DI float fexp(float x) { return __builtin_amdgcn_exp2f(x * 1.44269504089f); }
DI float frcp(float x) { return __builtin_amdgcn_rcpf(x); }
DI float sigm(float x) { return frcp(1.0f + fexp(-x)); }
DI float silu(float x) { return x * sigm(x); }
DI float flog(float x) { return __builtin_amdgcn_logf(x) * 0.69314718056f; }
DI float gelu1(float v) {
    const float av = __builtin_fabsf(v), d = av * 0.2316418882f + 1.0f, t = frcp(d);
    float q = t * 0.5307027145f + (-0.7265760135f); q = q * t + 0.7107068705f; q = q * t + (-0.142248368f); q = q * t + 0.127414796f; q = q * t;
    const float e = __builtin_amdgcn_exp2f((v * v) * (-0.72134752044f));
    const float m = v * (q * e), r = v - m;
    return v < 0.f ? m : r;
}
DI unsigned q8(float s) { return (unsigned)__builtin_fminf(__builtin_fmaxf(s * 255.0f + 0.5f, 1.0f), 255.0f); }
DI bf16x8 pack8(float a0, float a1, float a2, float a3, float a4, float a5, float a6, float a7) {
    u32x4 p; p.x = pk2(a0, a1); p.y = pk2(a2, a3); p.z = pk2(a4, a5); p.w = pk2(a6, a7); return __builtin_bit_cast(bf16x8, p);
}
#define MFMA32(a, b, c) __builtin_amdgcn_mfma_f32_32x32x16_bf16((a), (b), (c), 0, 0, 0)
DI int otid(int wv) { int l; asm volatile("v_mbcnt_lo_u32_b32 %0, -1, 0\n\tv_mbcnt_hi_u32_b32 %0, -1, %0" : "=v"(l)); return wv * 64 + l; }
DI f32x16 zero16() { f32x16 z; for (int i = 0; i < 16; ++i) z[i] = 0.f; return z; }

namespace pg {
constexpr int BM = 256, BK = 64, HALF = 128, HTB = HALF * BK * 2, NXCD = 8, WGM = 8;
DI int lds_byte(int r, int c) { const int st = (r >> 4) * 2 + (c >> 5), rr = r & 15, cc = c & 31, ob = rr * 64 + cc * 2; return st * 1024 + (ob ^ (((ob >> 9) & 1) << 5)); }
DI void stage_rc(int b, int& R, int& C) { const int st = b / 1024, sb = b % 1024, swz = sb ^ (((sb >> 9) & 1) << 5); R = (st >> 1) * 16 + swz / 64; C = (st & 1) * 32 + (swz % 64) / 2; }
DI int perm32(int rho) { const int n = rho >> 4, i = rho & 15; return 8 * (i >> 2) + 4 * n + (i & 3); }
struct Unit { int pm, pn, part; };

struct Order {
    int nM, nN, nwg, G, c, parts;
    DI void init(int M, int N, int G_, int c_, int parts_) { nM = M / BM; nN = N / BM; nwg = nM * nN; G = G_; c = c_; parts = parts_; }
    DI bool next(int i, Unit& u) const {
        const int ti = i / parts; u.part = i - ti * parts;
        const long L = (long)ti * G + c; if (L >= nwg) return false;
        int wgid = (int)L; { const int q = nwg / NXCD, r = nwg % NXCD, xcd = wgid % NXCD, off = wgid / NXCD; wgid = (xcd < r ? xcd * (q + 1) : r * (q + 1) + (xcd - r) * q) + off; }
        const int nig = WGM * nN, gid = wgid / nig, fm = gid * WGM, gsz = (nM - fm) < WGM ? (nM - fm) : WGM;
        u.pm = fm + ((wgid % nig) % gsz); u.pn = (wgid % nig) / gsz; return true;
    }
};

template <bool SWAP = false, class Src, class Epi>
DI void gemm_phase(const int wv, LAS unsigned char* lds, const int K, const Order& S, const Src& P, const Epi& E) {
    const int tid = otid(wv), wid = __builtin_amdgcn_readfirstlane(tid >> 6), lane = tid & 63, wr = wid >> 2, wc = wid & 3, fr = lane & 15, fq = lane >> 4;
    const int nt = K / BK;
    unsigned voffA[2], voffB[2];
#pragma unroll
    for (int i = 0; i < 2; ++i) { int R, C; stage_rc(tid * 16 + i * 8192, R, C); const int Rb = (R & ~31) + perm32(R & 31);
        voffA[i] = (unsigned)((SWAP ? Rb : R) * K + C) * 2u; voffB[i] = (unsigned)(Rb * K + C) * 2u; }
    const size_t kstep = (size_t)(BK * 2);
    const size_t hstep = (size_t)HALF * K * 2;
    const unsigned ldsw = (unsigned)wid * 1024u;
    const int aoff = lds_byte(wr * 64 + fr, fq * 8), boff = lds_byte(wc * 32 + fr, fq * 8);
#define PG_SA(b, h) (((b) * 2 + (h)) * HTB)
#define PG_SB(b, h) ((4 + (b) * 2 + (h)) * HTB)
#define PG_STAGE(bufoff, gbase, voff) do { _Pragma("unroll") for (int _i = 0; _i < 2; ++_i) \
        __builtin_amdgcn_global_load_lds((const unsigned*)((const char*)(gbase) + (voff)[_i]), (LAS unsigned*)(lds + (bufoff) + ldsw + _i * 8192), 16, 0, 0); } while (0)
#define PG_LDA(dst, b, h) do { _Pragma("unroll") for (int m = 0; m < 4; ++m) _Pragma("unroll") for (int k = 0; k < 2; ++k) dst[m][k] = *(const LAS bf16x8*)(lds + PG_SA(b, h) + aoff + m * 2048 + k * 1024); } while (0)
#define PG_LDB(dst, b, h) do { _Pragma("unroll") for (int n = 0; n < 2; ++n) _Pragma("unroll") for (int k = 0; k < 2; ++k) dst[n][k] = *(const LAS bf16x8*)(lds + PG_SB(b, h) + boff + n * 2048 + k * 1024); } while (0)
#define PG_MMA(ai, bj, At, Bt) do { __builtin_amdgcn_s_setprio(1); _Pragma("unroll") for (int m = 0; m < 4; ++m) _Pragma("unroll") for (int n = 0; n < 2; ++n) _Pragma("unroll") for (int k = 0; k < 2; ++k) \
        acc[ai][bj][m][n] = SWAP ? __builtin_amdgcn_mfma_f32_16x16x32_bf16(At[m][k], Bt[n][k], acc[ai][bj][m][n], 0, 0, 0) : __builtin_amdgcn_mfma_f32_16x16x32_bf16(Bt[n][k], At[m][k], acc[ai][bj][m][n], 0, 0, 0); __builtin_amdgcn_s_setprio(0); } while (0)
#define PG_WAIT_V(n) asm volatile("s_waitcnt vmcnt(" #n ")" ::: "memory")
#define PG_WAIT_L(n) asm volatile("s_waitcnt lgkmcnt(" #n ")" ::: "memory")
#define PG_BAR __builtin_amdgcn_s_barrier()
#define PG_SCHED __builtin_amdgcn_sched_barrier(0)
    Unit cur, nxt; int ui = 0;
    if (!S.next(0, cur)) return;
    f32x4 acc[2][2][4][2];
#pragma unroll
    for (int a = 0; a < 2; ++a)
#pragma unroll
        for (int b = 0; b < 2; ++b)
#pragma unroll
            for (int m = 0; m < 4; ++m)
#pragma unroll
                for (int n = 0; n < 2; ++n) acc[a][b][m][n] = (f32x4){0.f, 0.f, 0.f, 0.f};
    bf16x8 At[4][2], B0[2][2], B1[2][2];
    const char* cA = P.a(cur); const char* cB = P.b(cur); size_t cBh = P.bh(cur);
    PG_STAGE(PG_SB(0, 0), cB, voffB); PG_STAGE(PG_SA(0, 0), cA, voffA); PG_STAGE(PG_SB(0, 1), cB + cBh, voffB); PG_STAGE(PG_SA(0, 1), cA + hstep, voffA);
    if (wr == 1) PG_BAR;
    PG_WAIT_V(4); PG_BAR;
    PG_STAGE(PG_SB(1, 0), cB + kstep, voffB); PG_STAGE(PG_SA(1, 0), cA + kstep, voffA); PG_STAGE(PG_SB(1, 1), cB + cBh + kstep, voffB);
    PG_WAIT_V(6); PG_BAR;
    for (;;) {
        const bool has_next = S.next(ui + 1, nxt);
        const char* nA = has_next ? P.a(nxt) : cA; const char* nB = has_next ? P.b(nxt) : cB; const size_t nBh = has_next ? P.bh(nxt) : cBh;
        for (int t = 0; t < nt; t += 2) {
            const bool last = (t == nt - 2);
            const char* a1 = cA + (size_t)(t + 1) * kstep;
            const char* a2 = last ? nA : cA + (size_t)(t + 2) * kstep; const char* b2 = last ? nB : cB + (size_t)(t + 2) * kstep;
            const char* a3 = a2 + kstep; const char* b3 = b2 + kstep; const size_t bh2 = last ? nBh : cBh;
            PG_LDB(B0, 0, 0); PG_SCHED; PG_LDA(At, 0, 0); PG_STAGE(PG_SA(1, 1), a1 + hstep, voffA);
            PG_WAIT_L(8); PG_BAR; PG_WAIT_L(0); PG_MMA(0, 0, At, B0); PG_BAR; PG_SCHED;
            PG_LDB(B1, 0, 1); PG_STAGE(PG_SB(0, 0), b2, voffB);
            PG_BAR; PG_WAIT_L(0); PG_MMA(0, 1, At, B1); PG_BAR;
            PG_LDA(At, 0, 1); PG_STAGE(PG_SA(0, 0), a2, voffA);
            PG_BAR; PG_WAIT_L(0); PG_MMA(1, 0, At, B0); PG_BAR; PG_SCHED;
            PG_STAGE(PG_SB(0, 1), b2 + bh2, voffB);
            PG_WAIT_V(6); PG_BAR; PG_MMA(1, 1, At, B1); PG_BAR;
            PG_LDB(B0, 1, 0); PG_SCHED; PG_LDA(At, 1, 0); PG_STAGE(PG_SA(0, 1), a2 + hstep, voffA);
            PG_WAIT_L(8); PG_BAR; PG_WAIT_L(0); PG_MMA(0, 0, At, B0); PG_BAR; PG_SCHED;
            PG_LDB(B1, 1, 1); PG_STAGE(PG_SB(1, 0), b3, voffB);
            PG_BAR; PG_WAIT_L(0); PG_MMA(0, 1, At, B1); PG_BAR;
            PG_LDA(At, 1, 1); PG_STAGE(PG_SA(1, 0), a3, voffA);
            PG_BAR; PG_WAIT_L(0); PG_MMA(1, 0, At, B0); PG_BAR; PG_SCHED;
            PG_STAGE(PG_SB(1, 1), b3 + bh2, voffB);
            PG_WAIT_V(6); PG_BAR; PG_MMA(1, 1, At, B1); PG_BAR;
        }
        const bool keep = E(acc, cur, wr, wc, fr, fq);
        if (!has_next) break;
        if (!keep) {
#pragma unroll
            for (int a = 0; a < 2; ++a)
#pragma unroll
                for (int b = 0; b < 2; ++b)
#pragma unroll
                    for (int m = 0; m < 4; ++m)
#pragma unroll
                        for (int n = 0; n < 2; ++n) acc[a][b][m][n] = (f32x4){0.f, 0.f, 0.f, 0.f};
        }
        cur = nxt; cA = nA; cB = nB; cBh = nBh; ++ui;
    }
    PG_WAIT_V(0);
    if (wr == 0) PG_BAR;
    PG_BAR;
#undef PG_SA
#undef PG_SB
#undef PG_STAGE
#undef PG_LDA
#undef PG_LDB
#undef PG_MMA
#undef PG_WAIT_V
#undef PG_WAIT_L
#undef PG_BAR
#undef PG_SCHED
}
}
using pg::Unit;
typedef f32x4 AccT[2][2][4][2];

struct SrcIn {
    const char* A; const char* Bt; int split_pn, jump_rows;
    DI const char* a(const Unit& u) const { return A + (size_t)u.pm * 256 * D * 2; }
    DI const char* b(const Unit& u) const { const int row = (u.pn < split_pn) ? u.pn * 256 : jump_rows + (u.pn - split_pn) * 256; return Bt + (size_t)row * D * 2; }
    DI size_t bh(const Unit&) const { return (size_t)128 * D * 2; }
};
struct SrcOther {
    const char* A; const char* Bt;
    DI const char* a(const Unit& u) const { return A + (size_t)u.pm * 256 * D * 2; }
    DI const char* b(const Unit& u) const { const int row = (u.pn < 8) ? u.pn * 128 : (u.pn < 12) ? D + (u.pn - 8) * 256 : 7 * D + (u.pn - 12) * 128; return Bt + (size_t)row * D * 2; }
    DI size_t bh(const Unit& u) const { return (u.pn < 8) ? (size_t)2 * D * D * 2 : (u.pn < 12) ? (size_t)128 * D * 2 : (size_t)D * D * 2; }
};
struct SrcPlain { const char* A; const char* Bt; int K;
    DI const char* a(const Unit& u) const { return A + (size_t)u.pm * 256 * K * 2; }
    DI const char* b(const Unit& u) const { return Bt + (size_t)u.pn * 256 * K * 2; }
    DI size_t bh(const Unit&) const { return (size_t)128 * K * 2; }
};
struct SrcMerge { const char* A0; const char* A1; const char* B0; const char* B1;
    DI const char* a(const Unit& u) const { return (u.part ? A1 : A0) + (size_t)u.pm * 256 * D * 2; }
    DI const char* b(const Unit& u) const { return (u.part ? B1 : B0) + (size_t)u.pn * 256 * D * 2; }
    DI size_t bh(const Unit&) const { return (size_t)128 * D * 2; }
};

template <int MODE  >
struct EpiAct {
    bf16_t* base; size_t seg_stride; const float* lb; int plain;
    DI bool operator()(AccT& acc, const Unit& u, int wr, int wc, int fr, int fq) const {
        const int seg = u.pn >> 2;
        int act;
        if (MODE == 0) act = (seg == 0) ? 3 : (seg == 1) ? 4 : (seg == 2) ? 0 : 2;
        else act = (seg <= 1) ? 1 : (seg == 2) ? 2 : 5;
        if (plain) act = 0;
        bf16_t* ob = base + (size_t)seg * seg_stride;
        const int row0 = u.pm * 256 + wr * 64 + fr, col0 = (u.pn & 3) * 256 + wc * 32 + 8 * fq;
#pragma unroll
        for (int bj = 0; bj < 2; ++bj) {
            float oml[8];
            if (MODE == 0 && act == 4) {
                const f32x4 l0 = *(const f32x4*)(lb + col0 + bj * 128), l1 = *(const f32x4*)(lb + col0 + bj * 128 + 4);
#pragma unroll
                for (int j = 0; j < 4; ++j) { oml[j] = 1.0f - l0[j]; oml[4 + j] = 1.0f - l1[j]; }
            }
#pragma unroll
            for (int ai = 0; ai < 2; ++ai)
#pragma unroll
                for (int m = 0; m < 4; ++m) {
                    float v[8];
#pragma unroll
                    for (int j = 0; j < 4; ++j) { v[j] = acc[ai][bj][m][0][j]; v[4 + j] = acc[ai][bj][m][1][j]; }
                    if (act == 1) {
#pragma unroll
                        for (int j = 0; j < 8; ++j) v[j] = gelu1(v[j]);
                    } else if (act == 2) {
#pragma unroll
                        for (int j = 0; j < 8; ++j) v[j] = silu(v[j]);
                    } else if (act == 3) {
#pragma unroll
                        for (int j = 0; j < 8; ++j) v[j] = silu(v[j]) * 0.08838834764831845f;
                    } else if (act == 4) {
                        if (MODE == 0) {
#pragma unroll
                            for (int j = 0; j < 8; ++j) { const float kk = oml[j] * frcp(1.0f + fexp(v[j])); v[j] = flog(1.0f - kk); }
                        }
                    } else if (act == 5) {
#pragma unroll
                        for (int j = 0; j < 8; ++j) v[j] = sigm(v[j]);
                    }
                    u32x4 w; w.x = pk2(v[0], v[1]); w.y = pk2(v[2], v[3]); w.z = pk2(v[4], v[5]); w.w = pk2(v[6], v[7]);
                    *(u32x4*)(ob + (size_t)(row0 + ai * 128 + m * 16) * D + col0 + bj * 128) = w;
                }
        }
        return false;
    }
};


struct EpiScanT {
    bf16_t* base; size_t seg_stride; const float* lb;
    DI bool operator()(AccT& acc, const Unit& u, int wr, int wc, int fr, int fq) const {
        const int seg = u.pn >> 2;
        bf16_t* ob = base + (size_t)seg * seg_stride;
        const int c32 = 8 * (fr >> 2) + (fr & 3);
        float omls[4] = {0.f, 0.f, 0.f, 0.f};
        if (seg == 1) {
#pragma unroll
            for (int q = 0; q < 4; ++q) omls[q] = 1.0f - lb[(u.pn & 3) * 256 + (q >> 1) * 128 + wc * 32 + c32 + 4 * (q & 1)];
        }
#pragma unroll
        for (int bj = 0; bj < 2; ++bj)
#pragma unroll
            for (int n = 0; n < 2; ++n) {
                const int C = (u.pn & 3) * 256 + bj * 128 + wc * 32 + c32 + 4 * n;
                const int hd = C >> 7, ch = C & 127;
                const float oml = omls[bj * 2 + n];
#pragma unroll
                for (int ai = 0; ai < 2; ++ai)
#pragma unroll
                    for (int m2 = 0; m2 < 2; ++m2) {
                        const int row = u.pm * 256 + ai * 128 + wr * 64 + m2 * 32;
                        const int b = row >> 11, nc = (row & 2047) >> 5;
                        float v[8];
#pragma unroll
                        for (int j = 0; j < 4; ++j) { v[j] = acc[ai][bj][2 * m2][n][j]; v[4 + j] = acc[ai][bj][2 * m2 + 1][n][j]; }
                        if (seg == 0) {
#pragma unroll
                            for (int j = 0; j < 8; ++j) v[j] = silu(v[j]) * 0.08838834764831845f;
                        } else if (seg == 1) {
#pragma unroll
                            for (int j = 0; j < 8; ++j) { const float kk = oml * frcp(1.0f + fexp(v[j])); v[j] = flog(1.0f - kk); }
                        }
                        u32x4 w; w.x = pk2(v[0], v[1]); w.y = pk2(v[2], v[3]); w.z = pk2(v[4], v[5]); w.w = pk2(v[6], v[7]);
                        *(u32x4*)(ob + ((size_t)((b * 8 + hd) * 64 + nc)) * 4096 + fq * 1024 + ch * 8) = w;
                    }
            }
        return false;
    }
};
struct EpiSilu {
    bf16_t* outp;
    DI bool operator()(AccT& acc, const Unit& u, int wr, int wc, int fr, int fq) const {
        const int row0 = u.pm * 256 + wr * 64 + fr, col0 = u.pn * 256 + wc * 32 + 8 * fq;
#pragma unroll
        for (int ai = 0; ai < 2; ++ai)
#pragma unroll
            for (int m = 0; m < 4; ++m)
#pragma unroll
                for (int bj = 0; bj < 2; ++bj) {
                    float v[8];
#pragma unroll
                    for (int j = 0; j < 4; ++j) { v[j] = silu(acc[ai][bj][m][0][j]); v[4 + j] = silu(acc[ai][bj][m][1][j]); }
                    u32x4 w; w.x = pk2(v[0], v[1]); w.y = pk2(v[2], v[3]); w.z = pk2(v[4], v[5]); w.w = pk2(v[6], v[7]);
                    *(u32x4*)(outp + (size_t)(row0 + ai * 128 + m * 16) * D + col0 + bj * 128) = w;
                }
        return false;
    }
};
struct EpiOther {
    bf16_t* guz; bf16_t* gv; bf16_t* sg; f32x2* lnp;
    DI bool operator()(AccT& acc, const Unit& u, int wr, int wc, int fr, int fq) const {
        const int row0 = u.pm * 256 + wr * 64 + fr;
        if (u.pn < 8) {
            const int col0 = u.pn * 128 + wc * 32 + 8 * fq;
#pragma unroll
            for (int ai = 0; ai < 2; ++ai)
#pragma unroll
                for (int m = 0; m < 4; ++m) {
                    float v[8];
#pragma unroll
                    for (int j = 0; j < 4; ++j) { v[j] = gelu1(acc[ai][0][m][0][j]) * silu(acc[ai][1][m][0][j]); v[4 + j] = gelu1(acc[ai][0][m][1][j]) * silu(acc[ai][1][m][1][j]); }
                    u32x4 w; w.x = pk2(v[0], v[1]); w.y = pk2(v[2], v[3]); w.z = pk2(v[4], v[5]); w.w = pk2(v[6], v[7]);
                    *(u32x4*)(guz + (size_t)(row0 + ai * 128 + m * 16) * D + col0) = w;
                }
        } else if (u.pn < 12) {
            const int col0 = (u.pn - 8) * 256 + wc * 32 + 8 * fq;
#pragma unroll
            for (int ai = 0; ai < 2; ++ai)
#pragma unroll
                for (int m = 0; m < 4; ++m) {
                    const int row = row0 + ai * 128 + m * 16;
                    float s1 = 0.f, s2 = 0.f;
#pragma unroll
                    for (int bj = 0; bj < 2; ++bj) {
                        float v[8];
#pragma unroll
                        for (int j = 0; j < 4; ++j) { v[j] = gelu1(acc[ai][bj][m][0][j]); v[4 + j] = gelu1(acc[ai][bj][m][1][j]); }
#pragma unroll
                        for (int j = 0; j < 8; ++j) { s1 += v[j]; s2 += v[j] * v[j]; }
                        u32x4 w; w.x = pk2(v[0], v[1]); w.y = pk2(v[2], v[3]); w.z = pk2(v[4], v[5]); w.w = pk2(v[6], v[7]);
                        *(u32x4*)(gv + (size_t)row * D + col0 + bj * 128) = w;
                    }
                    s1 += __shfl_xor(s1, 16); s1 += __shfl_xor(s1, 32); s2 += __shfl_xor(s2, 16); s2 += __shfl_xor(s2, 32);
                    if (fq == 0) lnp[(size_t)row * 16 + (u.pn - 8) * 4 + wc] = (f32x2){s1, s2};
                }
        } else {
            const int col0 = (u.pn - 12) * 128 + wc * 32 + 8 * fq;
#pragma unroll
            for (int ai = 0; ai < 2; ++ai)
#pragma unroll
                for (int m = 0; m < 4; ++m) {
                    unsigned q[8];
#pragma unroll
                    for (int j = 0; j < 4; ++j) {
                        const float a0 = sigm(acc[ai][0][m][0][j]), a1 = sigm(acc[ai][0][m][1][j]), b0 = sigm(acc[ai][1][m][0][j]), b1 = sigm(acc[ai][1][m][1][j]);
                        q[j] = q8(a0) | (q8(b0) << 8); q[4 + j] = q8(a1) | (q8(b1) << 8);
                    }
                    u32x4 w; w.x = q[0] | (q[1] << 16); w.y = q[2] | (q[3] << 16); w.z = q[4] | (q[5] << 16); w.w = q[6] | (q[7] << 16);
                    *(u32x4*)(sg + (size_t)(row0 + ai * 128 + m * 16) * D + col0) = w;
                }
        }
        return false;
    }
};
struct EpiMerge {
    const bf16_t* sg; bf16_t* outp;
    DI bool operator()(AccT& acc, const Unit& u, int wr, int wc, int fr, int fq) const {
        const int row0 = u.pm * 256 + wr * 64 + fr, col0 = u.pn * 256 + wc * 32 + 8 * fq;
        if (u.part == 0) {
#pragma unroll
            for (int g = 0; g < 4; ++g) {
                const int ai = g >> 1, bj = g & 1;
                u32x4 gg[4];
#pragma unroll
                for (int m = 0; m < 4; ++m) gg[m] = *(const u32x4*)(sg + (size_t)(row0 + ai * 128 + m * 16) * D + col0 + bj * 128);
#pragma unroll
                for (int m = 0; m < 4; ++m) {
                    const unsigned w4[4] = {gg[m].x, gg[m].y, gg[m].z, gg[m].w};
#pragma unroll
                    for (int j = 0; j < 4; ++j) {
                        const float ra = (float)(w4[j] & 0xffu) * frcp((float)((w4[j] >> 8) & 0xffu)), rb = (float)((w4[j] >> 16) & 0xffu) * frcp((float)(w4[j] >> 24));
                        const int c0 = 2 * j, c1 = 2 * j + 1;
                        acc[ai][bj][m][c0 >> 2][c0 & 3] *= ra; acc[ai][bj][m][c1 >> 2][c1 & 3] *= rb;
                    }
                }
            }
            return true;
        }
        u32x4 cur[4], nxt[4];
#pragma unroll
        for (int m = 0; m < 4; ++m) cur[m] = *(const u32x4*)(sg + (size_t)(row0 + m * 16) * D + col0);
#pragma unroll
        for (int g = 0; g < 4; ++g) {
            const int ai = g >> 1, bj = g & 1;
            if (g < 3) { const int ai2 = (g + 1) >> 1, bj2 = (g + 1) & 1;
#pragma unroll
                for (int m = 0; m < 4; ++m) nxt[m] = *(const u32x4*)(sg + (size_t)(row0 + ai2 * 128 + m * 16) * D + col0 + bj2 * 128); }
#pragma unroll
            for (int m = 0; m < 4; ++m) {
                const unsigned w4[4] = {cur[m].x, cur[m].y, cur[m].z, cur[m].w};
                float v[8];
#pragma unroll
                for (int j = 0; j < 4; ++j) {
                    const int c0 = 2 * j, c1 = 2 * j + 1;
                    v[c0] = acc[ai][bj][m][c0 >> 2][c0 & 3] * ((float)((w4[j] >> 8) & 0xffu) * (1.0f / 255.0f));
                    v[c1] = acc[ai][bj][m][c1 >> 2][c1 & 3] * ((float)(w4[j] >> 24) * (1.0f / 255.0f));
                }
                u32x4 w; w.x = pk2(v[0], v[1]); w.y = pk2(v[2], v[3]); w.z = pk2(v[4], v[5]); w.w = pk2(v[6], v[7]);
                *(u32x4*)(outp + (size_t)(row0 + ai * 128 + m * 16) * D + col0 + bj * 128) = w;
            }
#pragma unroll
            for (int m = 0; m < 4; ++m) cur[m] = nxt[m];
        }
        return false;
    }
};
template <int MODE>
struct EpiRow {
    bf16_t* outp; float* ssq; const bf16_t* e; const float* bias;
    DI bool operator()(AccT& acc, const Unit& u, int wr, int wc, int fr, int fq) const {
        const int row0 = u.pm * 256 + wr * 64 + fr, col0 = u.pn * 256 + wc * 32 + 8 * fq;
        float bs[2][8];
        if (MODE == 2) {
#pragma unroll
            for (int bj = 0; bj < 2; ++bj) { const f32x4 b0 = *(const f32x4*)(bias + col0 + bj * 128), b1 = *(const f32x4*)(bias + col0 + bj * 128 + 4);
#pragma unroll
                for (int j = 0; j < 4; ++j) { bs[bj][j] = b0[j]; bs[bj][4 + j] = b1[j]; } }
        }
        u32x4 cur[4], nxt[4];
        if (MODE == 2) {
#pragma unroll
            for (int q = 0; q < 4; ++q) cur[q] = *(const u32x4*)(e + (size_t)(row0 + (q >> 1) * 16) * D + col0 + (q & 1) * 128);
        }
#pragma unroll
        for (int g = 0; g < 4; ++g) {
            const int ai = g >> 1, mp = g & 1;
            if (MODE == 2 && g < 3) { const int ai2 = (g + 1) >> 1, mp2 = (g + 1) & 1;
#pragma unroll
                for (int q = 0; q < 4; ++q) nxt[q] = *(const u32x4*)(e + (size_t)(row0 + ai2 * 128 + (mp2 * 2 + (q >> 1)) * 16) * D + col0 + (q & 1) * 128); }
#pragma unroll
            for (int mm = 0; mm < 2; ++mm) {
                const int m = mp * 2 + mm;
                const int row = row0 + ai * 128 + m * 16;
                float s = 0.f;
#pragma unroll
                for (int bj = 0; bj < 2; ++bj) {
                    const size_t off = (size_t)row * D + col0 + bj * 128;
                    float v[8];
#pragma unroll
                    for (int j = 0; j < 4; ++j) { v[j] = acc[ai][bj][m][0][j]; v[4 + j] = acc[ai][bj][m][1][j]; }
                    if (MODE == 2) {
                        const u32x4 ev = cur[mm * 2 + bj];
                        const float ef[8] = {bflo(ev.x), bfhi(ev.x), bflo(ev.y), bfhi(ev.y), bflo(ev.z), bfhi(ev.z), bflo(ev.w), bfhi(ev.w)};
#pragma unroll
                        for (int j = 0; j < 8; ++j) v[j] = ef[j] * sigm(v[j] + bs[bj][j]);
                    }
                    if (MODE != 1) {
#pragma unroll
                        for (int j = 0; j < 8; ++j) s += v[j] * v[j];
                    }
                    u32x4 w; w.x = pk2(v[0], v[1]); w.y = pk2(v[2], v[3]); w.z = pk2(v[4], v[5]); w.w = pk2(v[6], v[7]);
                    *(u32x4*)(outp + off) = w;
                }
                if (MODE != 1) {
                    s += __shfl_xor(s, 16); s += __shfl_xor(s, 32);
                    if (fq == 0) ssq[(size_t)row * 16 + u.pn * 4 + wc] = s;
                }
            }
            if (MODE == 2) {
#pragma unroll
                for (int q = 0; q < 4; ++q) cur[q] = nxt[q];
            }
        }
        return false;
    }
};


DI void rowstat_exchange(const float (&part)[2][4], LAS unsigned char* lds, float* xs, unsigned* cnt, const pg::Unit& u, int wr, int wc, int fr, int fq) {
    LAS float* P = (LAS float*)(lds + 131072); LAS float* S = P + 1024;
    const int wid = wr * 4 + wc, lane = fq * 16 + fr, tid = wid * 64 + lane;
#pragma unroll
    for (int ai = 0; ai < 2; ++ai)
#pragma unroll
        for (int m = 0; m < 4; ++m) {
            float sq = part[ai][m];
            sq += __shfl_xor(sq, 16); sq += __shfl_xor(sq, 32);
            if (fq == 0) P[(ai * 128 + wr * 64 + m * 16 + fr) * 4 + wc] = sq;
        }
    asm volatile("s_waitcnt lgkmcnt(0)" ::: "memory");
    if (wr == 0) __builtin_amdgcn_s_barrier();
    __builtin_amdgcn_s_barrier(); asm volatile("" ::: "memory");
    if (tid < 256) {
        const f32x4 p4 = *(const LAS f32x4*)(P + tid * 4);
        __hip_atomic_store(xs + ((size_t)u.pm * 256 + tid) * 4 + u.pn, (p4[0] + p4[1]) + (p4[2] + p4[3]), __ATOMIC_RELAXED, __HIP_MEMORY_SCOPE_AGENT);
    }
    asm volatile("s_waitcnt vmcnt(0)" ::: "memory");
    if (tid < 256 && lane == 0) __hip_atomic_fetch_add(cnt + u.pm * 16, 1u, __ATOMIC_RELAXED, __HIP_MEMORY_SCOPE_AGENT);
    if (wid == 0) {
        unsigned spins = 0;
        while ((unsigned)__builtin_amdgcn_readfirstlane(__hip_atomic_load(cnt + u.pm * 16, __ATOMIC_RELAXED, __HIP_MEMORY_SCOPE_AGENT)) < 16u) {
            __builtin_amdgcn_s_sleep(2);
            if (++spins > (1u << 22)) break;
        }
        __builtin_amdgcn_fence(__ATOMIC_ACQUIRE, "agent");
        asm volatile("s_waitcnt vmcnt(0)" ::: "memory");
    }
    asm volatile("" ::: "memory"); __builtin_amdgcn_s_barrier(); asm volatile("" ::: "memory");
    if (tid < 256) {
        const unsigned long long* sp = (const unsigned long long*)(xs + ((size_t)u.pm * 256 + tid) * 4);
        const unsigned long long a = __hip_atomic_load(sp, __ATOMIC_RELAXED, __HIP_MEMORY_SCOPE_AGENT), b = __hip_atomic_load(sp + 1, __ATOMIC_RELAXED, __HIP_MEMORY_SCOPE_AGENT);
        const float tot = (__uint_as_float((unsigned)a) + __uint_as_float((unsigned)(a >> 32))) + (__uint_as_float((unsigned)b) + __uint_as_float((unsigned)(b >> 32)));
        S[tid] = __builtin_amdgcn_rsqf(tot * (1.0f / D) + EPS);
    }
    asm volatile("s_waitcnt lgkmcnt(0)" ::: "memory");
    __builtin_amdgcn_s_barrier(); asm volatile("" ::: "memory");
}
DI void rowstat_end(int wr) { if (wr == 1) __builtin_amdgcn_s_barrier(); }

struct EpiX1 {
    const float* x; const float* g_post; bf16_t* x1b; float* xs; unsigned* cnt; LAS unsigned char* lds; size_t row_off;
    DI bool operator()(AccT& acc, const Unit& u, int wr, int wc, int fr, int fq) const {
        const int row0 = u.pm * 256 + wr * 64 + fr, col0 = u.pn * 256 + wc * 32 + 8 * fq;
        float part[2][4];
#pragma unroll
        for (int ai = 0; ai < 2; ++ai)
#pragma unroll
            for (int m = 0; m < 4; ++m) {
                float sq = 0.f;
#pragma unroll
                for (int bj = 0; bj < 2; ++bj)
#pragma unroll
                    for (int n = 0; n < 2; ++n)
#pragma unroll
                        for (int j = 0; j < 4; ++j) sq += acc[ai][bj][m][n][j] * acc[ai][bj][m][n][j];
                part[ai][m] = sq;
            }
        float gp[2][8];
#pragma unroll
        for (int bj = 0; bj < 2; ++bj) { const f32x4 g0 = *(const f32x4*)(g_post + col0 + bj * 128), g1 = *(const f32x4*)(g_post + col0 + bj * 128 + 4);
#pragma unroll
            for (int j = 0; j < 4; ++j) { gp[bj][j] = g0[j]; gp[bj][4 + j] = g1[j]; } }
        f32x4 cur[4], nxt[4];
#pragma unroll
        for (int q = 0; q < 4; ++q) cur[q] = *(const f32x4*)(x + (row_off + row0) * D + col0 + (q >> 1) * 128 + (q & 1) * 4);
        rowstat_exchange(part, lds, xs, cnt, u, wr, wc, fr, fq);
        const LAS float* S = (const LAS float*)(lds + 131072 + 4096);
#pragma unroll
        for (int g = 0; g < 8; ++g) {
            const int ai = g >> 2, m = g & 3;
            if (g < 7) { const int ai2 = (g + 1) >> 2, m2 = (g + 1) & 3;
#pragma unroll
                for (int q = 0; q < 4; ++q) nxt[q] = *(const f32x4*)(x + (row_off + row0 + ai2 * 128 + m2 * 16) * D + col0 + (q >> 1) * 128 + (q & 1) * 4); }
            const float rs = S[ai * 128 + wr * 64 + m * 16 + fr];
#pragma unroll
            for (int bj = 0; bj < 2; ++bj) {
                float v[8];
#pragma unroll
                for (int j = 0; j < 4; ++j) { v[j] = cur[bj * 2][j] + acc[ai][bj][m][0][j] * rs * gp[bj][j]; v[4 + j] = cur[bj * 2 + 1][j] + acc[ai][bj][m][1][j] * rs * gp[bj][4 + j]; }
                u32x4 w; w.x = pk2(v[0], v[1]); w.y = pk2(v[2], v[3]); w.z = pk2(v[4], v[5]); w.w = pk2(v[6], v[7]);
                *(u32x4*)(x1b + (size_t)(row0 + ai * 128 + m * 16) * D + col0 + bj * 128) = w;
            }
#pragma unroll
            for (int q = 0; q < 4; ++q) cur[q] = nxt[q];
        }
        rowstat_end(wr);
        return false;
    }
};

struct EpiOut {
    const bf16_t* e; const float* bias; const bf16_t* x1b; const float* g_ple; float* out; float* xs; unsigned* cnt; LAS unsigned char* lds; size_t row_off;
    DI bool operator()(AccT& acc, const Unit& u, int wr, int wc, int fr, int fq) const {
        { int l; asm volatile("v_mbcnt_lo_u32_b32 %0, -1, 0\n\tv_mbcnt_hi_u32_b32 %0, -1, %0" : "=v"(l)); fr = l & 15; fq = l >> 4; }
        const int row0 = u.pm * 256 + wr * 64 + fr, col0 = u.pn * 256 + wc * 32 + 8 * fq;
        const unsigned off0 = (unsigned)(row0 * D + col0);
        const char* eb = (const char*)e; const char* xb = (const char*)x1b; char* ob = (char*)(out + row_off * D);
        float part[2][4];
        {
            u32x4 ec = *(const u32x4*)(eb + (size_t)(off0 * 2u)), en = ec;
#pragma unroll
            for (int g = 0; g < 16; ++g) {
                const int ai = g >> 3, m = (g >> 1) & 3, bj = g & 1;
                if (g < 15) { const int ai2 = (g + 1) >> 3, m2 = ((g + 1) >> 1) & 3, bj2 = (g + 1) & 1;
                    en = *(const u32x4*)(eb + (size_t)((off0 + (ai2 * 128 + m2 * 16) * D + bj2 * 128) * 2u)); }
                const f32x4 b0 = *(const f32x4*)(bias + col0 + bj * 128), b1 = *(const f32x4*)(bias + col0 + bj * 128 + 4);
                const float ef[8] = {bflo(ec.x), bfhi(ec.x), bflo(ec.y), bfhi(ec.y), bflo(ec.z), bfhi(ec.z), bflo(ec.w), bfhi(ec.w)};
                float sq = 0.f;
#pragma unroll
                for (int j = 0; j < 4; ++j) {
                    const float v0 = ef[j] * sigm(acc[ai][bj][m][0][j] + b0[j]), v1 = ef[4 + j] * sigm(acc[ai][bj][m][1][j] + b1[j]);
                    acc[ai][bj][m][0][j] = v0; acc[ai][bj][m][1][j] = v1; sq += v0 * v0 + v1 * v1;
                }
                if (bj == 0) part[ai][m] = sq; else part[ai][m] += sq;
                ec = en;
            }
        }
        rowstat_exchange(part, lds, xs, cnt, u, wr, wc, fr, fq);
        const LAS float* S = (const LAS float*)(lds + 131072 + 4096);
        {
            f32x4 gq[2][2];
#pragma unroll
            for (int bj = 0; bj < 2; ++bj) { gq[bj][0] = *(const f32x4*)(g_ple + col0 + bj * 128); gq[bj][1] = *(const f32x4*)(g_ple + col0 + bj * 128 + 4); }
            u32x4 xc = *(const u32x4*)(xb + (size_t)(off0 * 2u)), xn = xc;
#pragma unroll
            for (int g = 0; g < 16; ++g) {
                const int ai = g >> 3, m = (g >> 1) & 3, bj = g & 1;
                if (g < 15) { const int ai2 = (g + 1) >> 3, m2 = ((g + 1) >> 1) & 3, bj2 = (g + 1) & 1;
                    xn = *(const u32x4*)(xb + (size_t)((off0 + (ai2 * 128 + m2 * 16) * D + bj2 * 128) * 2u)); }
                const float rs = S[ai * 128 + wr * 64 + m * 16 + fr];
                const f32x4 g0 = gq[bj][0], g1 = gq[bj][1];
                const float xf[8] = {bflo(xc.x), bfhi(xc.x), bflo(xc.y), bfhi(xc.y), bflo(xc.z), bfhi(xc.z), bflo(xc.w), bfhi(xc.w)};
                f32x4 o0, o1;
#pragma unroll
                for (int j = 0; j < 4; ++j) { o0[j] = xf[j] + acc[ai][bj][m][0][j] * rs * g0[j]; o1[j] = xf[4 + j] + acc[ai][bj][m][1][j] * rs * g1[j]; }
                char* op = ob + (size_t)((off0 + (ai * 128 + m * 16) * D + bj * 128) * 4u);
                *(f32x4*)op = o0; *(f32x4*)(op + 16) = o1;
                xc = xn;
            }
        }
        rowstat_end(wr);
        return false;
    }
};

struct TileRef { const float* src; bf16_t* dst; int K, N, k0, n0; };
DI bool tile_ref(const Params& p, int idx, TileRef& r) {
    constexpr int T0 = (D / 64) * (NCOLS / 64), T1 = (D / 64) * (D / 64), TP = (PLE / 64) * (D / 64);
    if (idx >= T0 + 4 * T1 + TP) return false;
    unsigned char* ws = p.ws;
    int t = idx; r.K = D; r.N = D;
    if (idx < T0) { r.src = p.w_in; r.dst = (bf16_t*)(ws + WS_WIN); r.N = NCOLS; }
    else if (idx < T0 + T1) { r.src = p.w_a; r.dst = (bf16_t*)(ws + WS_WA); t = idx - T0; }
    else if (idx < T0 + 2 * T1) { r.src = p.w_b; r.dst = (bf16_t*)(ws + WS_WB); t = idx - T0 - T1; }
    else if (idx < T0 + 3 * T1) { r.src = p.w_out; r.dst = (bf16_t*)(ws + WS_WO); t = idx - T0 - 2 * T1; }
    else if (idx < T0 + 4 * T1) { r.src = p.w_gate; r.dst = (bf16_t*)(ws + WS_WG); t = idx - T0 - 3 * T1; }
    else { r.src = p.w_ple; r.dst = (bf16_t*)(ws + WS_WP); r.K = PLE; t = idx - T0 - 4 * T1; }
    const int nn = r.N / 64; r.k0 = (t / nn) * 64; r.n0 = (t % nn) * 64;
    return true;
}
DI void transpose_all(const int wv, const Params& p, LAS float* tiles) {
    const int tid = otid(wv), ty = tid >> 4, tx = tid & 15, n = tid >> 3, kq = tid & 7;
    int idx = blockIdx.x, buf = 0;
    TileRef cur, nxt; bool have = tile_ref(p, idx, cur);
    f32x4 v0, v1;
    if (have) { v0 = *(const f32x4*)(cur.src + (size_t)(cur.k0 + ty) * cur.N + cur.n0 + tx * 4); v1 = *(const f32x4*)(cur.src + (size_t)(cur.k0 + ty + 32) * cur.N + cur.n0 + tx * 4); }
    while (have) {
        LAS float* tile = tiles + buf * (64 * 65);
        tile[ty * 65 + tx * 4 + 0] = v0[0]; tile[ty * 65 + tx * 4 + 1] = v0[1]; tile[ty * 65 + tx * 4 + 2] = v0[2]; tile[ty * 65 + tx * 4 + 3] = v0[3];
        tile[(ty + 32) * 65 + tx * 4 + 0] = v1[0]; tile[(ty + 32) * 65 + tx * 4 + 1] = v1[1]; tile[(ty + 32) * 65 + tx * 4 + 2] = v1[2]; tile[(ty + 32) * 65 + tx * 4 + 3] = v1[3];
        idx += gridDim.x;
        const bool hn = tile_ref(p, idx, nxt);
        if (hn) { v0 = *(const f32x4*)(nxt.src + (size_t)(nxt.k0 + ty) * nxt.N + nxt.n0 + tx * 4); v1 = *(const f32x4*)(nxt.src + (size_t)(nxt.k0 + ty + 32) * nxt.N + nxt.n0 + tx * 4); }
        __syncthreads();
        float t[8];
#pragma unroll
        for (int j = 0; j < 8; ++j) t[j] = tile[(kq * 8 + j) * 65 + n];
        u32x4 w; w.x = pk2(t[0], t[1]); w.y = pk2(t[2], t[3]); w.z = pk2(t[4], t[5]); w.w = pk2(t[6], t[7]);
        *(u32x4*)(cur.dst + (size_t)(cur.n0 + n) * cur.K + cur.k0 + kq * 8) = w;
        buf ^= 1; cur = nxt; have = hn;
    }
    __syncthreads();
}
DI void phase0(const int wv, const Params& p, LAS unsigned char* lds) {
    unsigned char* ws = p.ws;
    transpose_all(wv, p, (LAS float*)lds);
    const int tid = otid(wv), lane = tid & 63, wid = tid >> 6;
    if (blockIdx.x == 0) {
        float* lb = (float*)(ws + WS_LB);
        for (int c = tid; c < D; c += NTHREADS) lb[c] = frcp(1.0f + fexp(p.lb_logits[D + c] - p.lb_logits[c]));
    }
    {
        bf16_t* h = (bf16_t*)(ws + WS_H);
        f32x4 g[4];
#pragma unroll
        for (int i = 0; i < 4; ++i) g[i] = *(const f32x4*)(p.g_pre + lane * 4 + 256 * i);
        for (int row = (blockIdx.x * 8 + wid) * 2; row < M_TOT; row += gridDim.x * 16) {
            f32x4 v[2][4]; float rs[2];
#pragma unroll
            for (int r2 = 0; r2 < 2; ++r2) {
                const float* xr = p.x + (size_t)(row + r2) * D;
#pragma unroll
                for (int i = 0; i < 4; ++i) v[r2][i] = *(const f32x4*)(xr + lane * 4 + 256 * i);
            }
#pragma unroll
            for (int r2 = 0; r2 < 2; ++r2) {
                float ss = 0.f;
#pragma unroll
                for (int i = 0; i < 4; ++i) ss += v[r2][i][0] * v[r2][i][0] + v[r2][i][1] * v[r2][i][1] + v[r2][i][2] * v[r2][i][2] + v[r2][i][3] * v[r2][i][3];
#pragma unroll
                for (int o = 32; o >= 1; o >>= 1) ss += __shfl_xor(ss, o);
                rs[r2] = __builtin_amdgcn_rsqf(ss * (1.0f / D) + EPS);
            }
#pragma unroll
            for (int r2 = 0; r2 < 2; ++r2)
#pragma unroll
                for (int i = 0; i < 4; ++i) { u32x2 w; w.x = pk2(v[r2][i][0] * rs[r2] * g[i][0], v[r2][i][1] * rs[r2] * g[i][1]); w.y = pk2(v[r2][i][2] * rs[r2] * g[i][2], v[r2][i][3] * rs[r2] * g[i][3]);
                    *(u32x2*)(h + (size_t)(row + r2) * D + lane * 4 + 256 * i) = w; }
        }
    }
    {
        bf16_t* pb = (bf16_t*)(ws + WS_PBF);
        const size_t n8 = (size_t)M_TOT * PLE / 8;
        for (size_t i = (size_t)blockIdx.x * NTHREADS + tid; i < n8; i += (size_t)gridDim.x * NTHREADS) {
            const f32x4 a = *(const f32x4*)(p.p + i * 8), b = *(const f32x4*)(p.p + i * 8 + 4);
            u32x4 w; w.x = pk2(a[0], a[1]); w.y = pk2(a[2], a[3]); w.z = pk2(b[0], b[1]); w.w = pk2(b[2], b[3]);
            *(u32x4*)(pb + i * 8) = w;
        }
    }
}

constexpr int HG_SET = 38400, HG_QN = 0, HG_KN = 8704, HG_KT = 17408, HG_VT = 27648, HG_DEC = 37888, HG_TOT = 2 * HG_SET, HG_OB = HG_TOT + 2 * 2048, HG_OBSZ = 2 * 32 * 132 * 4;
static_assert(HG_OB + 2 * HG_OBSZ <= LDS_MISC, "HGRN LDS overflow");
DI void hgrn_item(const int wv, LAS unsigned char* lds, const bf16_t* Q, const bf16_t* LF, const bf16_t* V, const bf16_t* ZB, bf16_t* GB, const float* norm_g, const size_t rowbase) {
    const int tid = otid(wv), wid = __builtin_amdgcn_readfirstlane(tid >> 6), lane = tid & 63, r = lane & 31, h = lane >> 5;
    constexpr int NCH = SEQ / 32;
    if (wid < 4) {
        const int vb = wid;
        f32x16 S[4];
#pragma unroll
        for (int i = 0; i < 4; ++i) S[i] = zero16();
        __syncthreads();
        for (int n = 0; n < NCH; ++n) {
            LAS unsigned char* ib = lds + (n & 1) * HG_SET;
            LAS float* Ob = (LAS float*)(lds + HG_OB + (n & 1) * HG_OBSZ);
            f32x16 P = zero16();
#pragma unroll
            for (int ks = 0; ks < 8; ++ks) {
                const bf16x8 a = *(const LAS bf16x8*)(ib + HG_KN + r * 272 + (16 * ks + 8 * h) * 2);
                const bf16x8 b = *(const LAS bf16x8*)(ib + HG_QN + r * 272 + (16 * ks + 8 * h) * 2);
                P = MFMA32(a, b, P);
            }
#pragma unroll
            for (int i = 0; i < 16; ++i) { const int s = (i & 3) + 8 * (i >> 2) + 4 * h; P[i] = (s <= r) ? P[i] : 0.f; }
            f32x16 o = zero16();
#pragma unroll
            for (int k2 = 0; k2 < 2; ++k2) {
                const bf16x8 pa = k2 ? pack8(P[8], P[9], P[10], P[11], P[12], P[13], P[14], P[15]) : pack8(P[0], P[1], P[2], P[3], P[4], P[5], P[6], P[7]);
                const s16x4 lo = *(const LAS s16x4*)(ib + HG_VT + (32 * vb + r) * 80 + (16 * k2 + 4 * h) * 2);
                const s16x4 hi = *(const LAS s16x4*)(ib + HG_VT + (32 * vb + r) * 80 + (16 * k2 + 8 + 4 * h) * 2);
                const bf16x8 pb = __builtin_shufflevector(lo, hi, 0, 1, 2, 3, 4, 5, 6, 7);
                o = MFMA32(pa, pb, o);
            }
#pragma unroll
            for (int db = 0; db < 4; ++db) {
#pragma unroll
                for (int s2 = 0; s2 < 2; ++s2) {
                    const bf16x8 xs = s2 ? pack8(S[db][8], S[db][9], S[db][10], S[db][11], S[db][12], S[db][13], S[db][14], S[db][15]) : pack8(S[db][0], S[db][1], S[db][2], S[db][3], S[db][4], S[db][5], S[db][6], S[db][7]);
                    const s16x4 lo = *(const LAS s16x4*)(ib + HG_QN + r * 272 + (32 * db + 16 * s2 + 4 * h) * 2);
                    const s16x4 hi = *(const LAS s16x4*)(ib + HG_QN + r * 272 + (32 * db + 16 * s2 + 8 + 4 * h) * 2);
                    const bf16x8 pa = __builtin_shufflevector(lo, hi, 0, 1, 2, 3, 4, 5, 6, 7);
                    o = MFMA32(pa, xs, o);
                }
            }
#pragma unroll
            for (int db = 0; db < 4; ++db) {
#pragma unroll
                for (int ks = 0; ks < 2; ++ks) {
                    const bf16x8 a = *(const LAS bf16x8*)(ib + HG_KT + (32 * db + r) * 80 + (16 * ks + 8 * h) * 2);
                    const bf16x8 b = *(const LAS bf16x8*)(ib + HG_VT + (32 * vb + r) * 80 + (16 * ks + 8 * h) * 2);
                    S[db] = MFMA32(a, b, S[db]);
                }
#pragma unroll
                for (int gq = 0; gq < 4; ++gq) { const f32x4 dv = *(const LAS f32x4*)(ib + HG_DEC + (32 * db + 8 * gq + 4 * h) * 4);
#pragma unroll
                    for (int j = 0; j < 4; ++j) S[db][4 * gq + j] *= dv[j]; }
            }
#pragma unroll
            for (int i = 0; i < 16; ++i) { const int t = (i & 3) + 8 * (i >> 2) + 4 * h; Ob[t * 132 + 32 * vb + r] = o[i]; }
            __syncthreads();
        }
        __syncthreads();
        return;
    }
    const int d = (wid - 4) * 32 + (lane & 31), th = lane >> 5;
    const int tl = (wid - 4) * 64 + lane, et = tl >> 3, ev0 = (tl & 7) * 16;
    float ng[16];
#pragma unroll
    for (int j = 0; j < 16; ++j) ng[j] = norm_g[ev0 + j];
    u32x4 rq[4][2], rl[4][2], rv[4][2], rz[4][2];
#define HG_LOAD(n, K) do { _Pragma("unroll") for (int s_ = 0; s_ < 2; ++s_) { const size_t co = (size_t)(n) * 4096 + (2 * th + s_) * 1024 + d * 8; \
        rq[K][s_] = *(const u32x4*)(Q + co); rl[K][s_] = *(const u32x4*)(LF + co); rv[K][s_] = *(const u32x4*)(V + co); } } while (0)
#define HG_ELEM(n, K) do { \
        LAS unsigned char* ib_ = lds + ((n) & 1) * HG_SET; \
        const unsigned lw[8] = {rl[K][0].x, rl[K][0].y, rl[K][0].z, rl[K][0].w, rl[K][1].x, rl[K][1].y, rl[K][1].z, rl[K][1].w}; \
        const unsigned qw[8] = {rq[K][0].x, rq[K][0].y, rq[K][0].z, rq[K][0].w, rq[K][1].x, rq[K][1].y, rq[K][1].z, rq[K][1].w}; \
        float c[16]; float run = 0.f; \
        _Pragma("unroll") for (int j = 0; j < 8; ++j) { run += bflo(lw[j]); c[2 * j] = run; run += bfhi(lw[j]); c[2 * j + 1] = run; } \
        const float other = __shfl_xor(run, 32); \
        const float offc = th ? other : 0.f; \
        if (th == 0) ((LAS float*)(ib_ + HG_DEC))[d] = fexp(run + other); \
        float kvv[16], qvv[16]; float invp = fexp(fminf(-offc, 80.0f)); \
        _Pragma("unroll") for (int j = 0; j < 16; ++j) { \
            const float cum = offc + c[j]; \
            const float e = fexp(cum), inv = fexp(fminf(-cum, 80.0f)); \
            const float qf = (j & 1) ? bfhi(qw[j >> 1]) : bflo(qw[j >> 1]); \
            qvv[j] = qf * e; \
            kvv[j] = (1.0f - e * invp) * inv; \
            invp = inv; \
        } \
        unsigned kp[8], qp[8]; \
        _Pragma("unroll") for (int i = 0; i < 8; ++i) { kp[i] = pk2(kvv[2 * i], kvv[2 * i + 1]); qp[i] = pk2(qvv[2 * i], qvv[2 * i + 1]); } \
          \
        { const int odd_ = lane & 1; LAS unsigned* qn_ = (LAS unsigned*)(ib_ + HG_QN + ((16 * th + odd_) * 136 + (d - odd_)) * 2); LAS unsigned* kn_ = (LAS unsigned*)(ib_ + HG_KN + ((16 * th + odd_) * 136 + (d - odd_)) * 2); \
          _Pragma("unroll") for (int i = 0; i < 8; ++i) { \
            const unsigned nq = (unsigned)__shfl_xor((int)qp[i], 1), nk = (unsigned)__shfl_xor((int)kp[i], 1); \
            qn_[i * 136] = odd_ ? ((nq >> 16) | (qp[i] & 0xffff0000u)) : ((qp[i] & 0xffffu) | (nq << 16)); \
            kn_[i * 136] = odd_ ? ((nk >> 16) | (kp[i] & 0xffff0000u)) : ((kp[i] & 0xffffu) | (nk << 16)); \
          } } \
        *(LAS u32x4*)(ib_ + HG_KT + d * 80 + (16 * th) * 2) = (u32x4){kp[0], kp[1], kp[2], kp[3]}; \
        *(LAS u32x4*)(ib_ + HG_KT + d * 80 + (16 * th + 8) * 2) = (u32x4){kp[4], kp[5], kp[6], kp[7]}; \
        *(LAS u32x4*)(ib_ + HG_VT + d * 80 + (16 * th) * 2) = rv[K][0]; \
        *(LAS u32x4*)(ib_ + HG_VT + d * 80 + (16 * th + 8) * 2) = rv[K][1]; \
    } while (0)
#define HG_EPI(n, K) do { \
        const LAS unsigned char* ob_ = lds + HG_OB + ((n) & 1) * HG_OBSZ + (et * 132 + ev0) * 4; \
        float ov[16]; float ss = 0.f; \
        _Pragma("unroll") for (int q_ = 0; q_ < 4; ++q_) { const f32x4 a_ = *(const LAS f32x4*)(ob_ + q_ * 16); ov[4 * q_] = a_[0]; ov[4 * q_ + 1] = a_[1]; ov[4 * q_ + 2] = a_[2]; ov[4 * q_ + 3] = a_[3]; } \
        _Pragma("unroll") for (int j = 0; j < 16; ++j) ss += ov[j] * ov[j]; \
        ss += __shfl_xor(ss, 1); ss += __shfl_xor(ss, 2); ss += __shfl_xor(ss, 4); \
        const float rs = __builtin_amdgcn_rsqf(ss * (1.0f / 128.0f) + EPS); \
        const unsigned zw[8] = {rz[K][0].x, rz[K][0].y, rz[K][0].z, rz[K][0].w, rz[K][1].x, rz[K][1].y, rz[K][1].z, rz[K][1].w}; \
        unsigned wq[8]; \
        _Pragma("unroll") for (int j = 0; j < 8; ++j) wq[j] = pk2(ov[2 * j] * rs * ng[2 * j] * bflo(zw[j]), ov[2 * j + 1] * rs * ng[2 * j + 1] * bfhi(zw[j])); \
        bf16_t* gp_ = GB + rowbase + (size_t)((n) * 32 + et) * D + ev0; \
        *(u32x4*)gp_ = (u32x4){wq[0], wq[1], wq[2], wq[3]}; *(u32x4*)(gp_ + 8) = (u32x4){wq[4], wq[5], wq[6], wq[7]}; \
    } while (0)
#define HG_LOADZ(n, K) do { const bf16_t* zp_ = ZB + rowbase + (size_t)((n) * 32 + et) * D + ev0; rz[K][0] = *(const u32x4*)zp_; rz[K][1] = *(const u32x4*)(zp_ + 8); } while (0)
    HG_LOAD(0, 0); HG_LOAD(1, 1); HG_LOAD(2, 2); HG_LOAD(3, 3);
    HG_LOADZ(0, 0); HG_LOADZ(1, 1); HG_LOADZ(2, 2);
    HG_ELEM(0, 0);
    HG_LOAD(4, 0);
    __syncthreads();
#define HG_TRIP(n, K) do { \
        if ((n) + 1 < NCH) { HG_ELEM((n) + 1, ((K) + 1) & 3); if ((n) + 5 < NCH) HG_LOAD((n) + 5, ((K) + 1) & 3); } \
        if ((n) >= 1) HG_EPI((n) - 1, ((K) + 3) & 3); \
        if ((n) + 3 < NCH) HG_LOADZ((n) + 3, ((K) + 3) & 3); \
        __syncthreads(); \
    } while (0)
#pragma unroll 1
    for (int n = 0; n < NCH; n += 4) { HG_TRIP(n, 0); HG_TRIP(n + 1, 1); HG_TRIP(n + 2, 2); HG_TRIP(n + 3, 3); }
#undef HG_TRIP
    HG_EPI(NCH - 1, (NCH - 1) & 3);
    __syncthreads();
#undef HG_LOAD
#undef HG_ELEM
#undef HG_EPI
#undef HG_LOADZ
}

constexpr int GM_MU = 0, GM_RS = 512, GM_VT = 1024, GM_WS = 70656;
DI void gmlp_item(const int wv, LAS unsigned char* lds, const Params& p, const bf16_t* GUZ, const bf16_t* GV, const f32x2* LNP, bf16_t* GA, const int ch, const int g) {
    const int tid = otid(wv), wid = __builtin_amdgcn_readfirstlane(tid >> 6), lane = tid & 63, r = lane & 31, h = lane >> 5;
    LAS float* mu = (LAS float*)(lds + GM_MU); LAS float* rsd = (LAS float*)(lds + GM_RS);
    const size_t R0 = (size_t)ch * 128;
    if (tid < 128) {
        const f32x4* pp = (const f32x4*)(LNP + (R0 + tid) * 16);
        float s1 = 0.f, s2 = 0.f;
#pragma unroll
        for (int i = 0; i < 8; ++i) { const f32x4 q = pp[i]; s1 += q[0] + q[2]; s2 += q[1] + q[3]; }
        const float mean = s1 * (1.0f / D); const float var = fmaxf(s2 * (1.0f / D) - mean * mean, 0.f);
        mu[tid] = mean; rsd[tid] = __builtin_amdgcn_rsqf(var + EPS);
    }
    {
        const int t = tid >> 2, s0 = (tid & 3) * 32;
        const float* wp = p.w_s + ((size_t)g * 128 + t) * 128 + s0;
#pragma unroll
        for (int q = 0; q < 4; ++q) {
            const f32x4 a = *(const f32x4*)(wp + q * 8), b = *(const f32x4*)(wp + q * 8 + 4);
            float v[8] = {a[0], a[1], a[2], a[3], b[0], b[1], b[2], b[3]};
#pragma unroll
            for (int j = 0; j < 8; ++j) v[j] = (s0 + q * 8 + j <= t) ? v[j] : 0.f;
            u32x4 w; w.x = pk2(v[0], v[1]); w.y = pk2(v[2], v[3]); w.z = pk2(v[4], v[5]); w.w = pk2(v[6], v[7]);
            *(LAS u32x4*)(lds + GM_WS + t * 272 + (s0 + q * 8) * 2) = w;
        }
    }
    __syncthreads();
    for (int it = 0; it < 8; ++it) {
        const int idx = it * NTHREADS + tid, s = idx & 127, c8 = idx >> 7;
        const int cg0 = g * 256 + c8 * 8;
        const u32x4 a = *(const u32x4*)(GV + (R0 + s) * D + cg0);
        const f32x4 g0 = *(const f32x4*)(p.ln_g + cg0), g1 = *(const f32x4*)(p.ln_g + cg0 + 4), b0 = *(const f32x4*)(p.ln_b + cg0), b1 = *(const f32x4*)(p.ln_b + cg0 + 4);
        const float f[8] = {bflo(a.x), bfhi(a.x), bflo(a.y), bfhi(a.y), bflo(a.z), bfhi(a.z), bflo(a.w), bfhi(a.w)};
        const float gg[8] = {g0[0], g0[1], g0[2], g0[3], g1[0], g1[1], g1[2], g1[3]};
        const float bb[8] = {b0[0], b0[1], b0[2], b0[3], b1[0], b1[1], b1[2], b1[3]};
        const float m = mu[s], rs = rsd[s];
#pragma unroll
        for (int j = 0; j < 8; ++j) {
            const float y = (f[j] - m) * rs * gg[j] + bb[j];
            *(LAS bf16_t*)(lds + GM_VT + (c8 * 8 + j) * 272 + s * 2) = (bf16_t)(pk2(y, 0.f) & 0xffffu);
        }
    }
    __syncthreads();
    f32x16 acc[4];
#pragma unroll
    for (int tb = 0; tb < 4; ++tb) acc[tb] = zero16();
#pragma unroll
    for (int ks = 0; ks < 8; ++ks) {
        const bf16x8 a = *(const LAS bf16x8*)(lds + GM_VT + (32 * wid + r) * 272 + (16 * ks + 8 * h) * 2);
#pragma unroll
        for (int tb = 0; tb < 4; ++tb) {
            if (ks <= 2 * tb + 1) {
                const bf16x8 b = *(const LAS bf16x8*)(lds + GM_WS + (32 * tb + r) * 272 + (16 * ks + 8 * h) * 2);
                acc[tb] = MFMA32(a, b, acc[tb]);
            }
        }
    }
    __syncthreads();
#pragma unroll
    for (int tb = 0; tb < 4; ++tb) {
        const int t = 32 * tb + r;
        const float bsv = p.b_s[g * 128 + t];
#pragma unroll
        for (int gq = 0; gq < 4; ++gq) {
            u32x2 w; w.x = pk2(acc[tb][4 * gq] + bsv, acc[tb][4 * gq + 1] + bsv); w.y = pk2(acc[tb][4 * gq + 2] + bsv, acc[tb][4 * gq + 3] + bsv);
            *(LAS u32x2*)(lds + GM_VT + t * 528 + (32 * wid + 8 * gq + 4 * h) * 2) = w;
        }
    }
    __syncthreads();
    {
        u32x4 uu[8];
#pragma unroll
        for (int it = 0; it < 8; ++it) { const int idx = it * NTHREADS + tid, t = idx >> 5, c8 = idx & 31; uu[it] = *(const u32x4*)(GUZ + (R0 + t) * D + g * 256 + c8 * 8); }
#pragma unroll
        for (int it = 0; it < 8; ++it) {
            const int idx = it * NTHREADS + tid, t = idx >> 5, c8 = idx & 31;
            const u32x4 oo = *(const LAS u32x4*)(lds + GM_VT + t * 528 + c8 * 16);
            u32x4 w;
            w.x = pk2(bflo(uu[it].x) * bflo(oo.x), bfhi(uu[it].x) * bfhi(oo.x));
            w.y = pk2(bflo(uu[it].y) * bflo(oo.y), bfhi(uu[it].y) * bfhi(oo.y));
            w.z = pk2(bflo(uu[it].z) * bflo(oo.z), bfhi(uu[it].z) * bfhi(oo.z));
            w.w = pk2(bflo(uu[it].w) * bflo(oo.w), bfhi(uu[it].w) * bfhi(oo.w));
            *(u32x4*)(GA + (R0 + t) * D + g * 256 + c8 * 8) = w;
        }
    }
    __syncthreads();
}

DI float row_rs(const float* ssq, size_t grow, int lane) {
    float s = ssq[grow * 16 + (lane & 15)];
    s += __shfl_xor(s, 1); s += __shfl_xor(s, 2); s += __shfl_xor(s, 4); s += __shfl_xor(s, 8);
    return __builtin_amdgcn_rsqf(s * (1.0f / D) + EPS);
}
DI void x1_rows(const int wv, const Params& p, const int slice, const bf16_t* T, const float* ssq1, bf16_t* X1B) {
    const int tid = otid(wv), lane = tid & 63, wid = tid >> 6;
    f32x4 g[4];
#pragma unroll
    for (int i = 0; i < 2; ++i) { g[2 * i] = *(const f32x4*)(p.g_post + lane * 8 + 512 * i); g[2 * i + 1] = *(const f32x4*)(p.g_post + lane * 8 + 512 * i + 4); }
    for (int rr = (blockIdx.x * 8 + wid) * 2; rr < MS; rr += gridDim.x * 16) {
        f32x4 xv[2][4]; u32x4 tv[2][2]; float rs[2];
#pragma unroll
        for (int r2 = 0; r2 < 2; ++r2) {
            const size_t grow = (size_t)slice * MS + rr + r2;
            rs[r2] = row_rs(ssq1, grow, lane);
#pragma unroll
            for (int i = 0; i < 2; ++i) { const int c = lane * 8 + 512 * i;
                xv[r2][2 * i] = *(const f32x4*)(p.x + grow * D + c); xv[r2][2 * i + 1] = *(const f32x4*)(p.x + grow * D + c + 4);
                tv[r2][i] = *(const u32x4*)(T + (size_t)(rr + r2) * D + c); }
        }
#pragma unroll
        for (int r2 = 0; r2 < 2; ++r2)
#pragma unroll
            for (int i = 0; i < 2; ++i) {
                const int c = lane * 8 + 512 * i; const f32x4 x0 = xv[r2][2 * i], x1 = xv[r2][2 * i + 1], g0 = g[2 * i], g1 = g[2 * i + 1]; const u32x4 t4 = tv[r2][i]; const float r = rs[r2];
                u32x4 w;
                w.x = pk2(x0[0] + bflo(t4.x) * r * g0[0], x0[1] + bfhi(t4.x) * r * g0[1]);
                w.y = pk2(x0[2] + bflo(t4.y) * r * g0[2], x0[3] + bfhi(t4.y) * r * g0[3]);
                w.z = pk2(x1[0] + bflo(t4.z) * r * g1[0], x1[1] + bfhi(t4.z) * r * g1[1]);
                w.w = pk2(x1[2] + bflo(t4.w) * r * g1[2], x1[3] + bfhi(t4.w) * r * g1[3]);
                *(u32x4*)(X1B + (size_t)(rr + r2) * D + c) = w;
            }
    }
}
DI void final_rows(const int wv, const Params& p, const int slice, const bf16_t* X1B, const bf16_t* EG, const float* ssq2) {
    const int tid = otid(wv), lane = tid & 63, wid = tid >> 6;
    f32x4 q[4];
#pragma unroll
    for (int i = 0; i < 2; ++i) { q[2 * i] = *(const f32x4*)(p.g_ple + lane * 8 + 512 * i); q[2 * i + 1] = *(const f32x4*)(p.g_ple + lane * 8 + 512 * i + 4); }
    for (int rr = (blockIdx.x * 8 + wid) * 4; rr < MS; rr += gridDim.x * 32) {
        u32x4 xv[4][2], ev[4][2]; float rs2[4];
#pragma unroll
        for (int r2 = 0; r2 < 4; ++r2) {
            const size_t grow = (size_t)slice * MS + rr + r2;
            rs2[r2] = row_rs(ssq2, grow, lane);
#pragma unroll
            for (int i = 0; i < 2; ++i) { const int c = lane * 8 + 512 * i;
                xv[r2][i] = *(const u32x4*)(X1B + (size_t)(rr + r2) * D + c); ev[r2][i] = *(const u32x4*)(EG + (size_t)(rr + r2) * D + c); }
        }
#pragma unroll
        for (int r2 = 0; r2 < 4; ++r2)
#pragma unroll
            for (int i = 0; i < 2; ++i) {
                const int c = lane * 8 + 512 * i; const size_t grow = (size_t)slice * MS + rr + r2;
                const f32x4 q0 = q[2 * i], q1 = q[2 * i + 1]; const u32x4 x4 = xv[r2][i], e4 = ev[r2][i]; const float r2s = rs2[r2];
                f32x4 o0, o1;
                o0[0] = bflo(x4.x) + bflo(e4.x) * r2s * q0[0]; o0[1] = bfhi(x4.x) + bfhi(e4.x) * r2s * q0[1];
                o0[2] = bflo(x4.y) + bflo(e4.y) * r2s * q0[2]; o0[3] = bfhi(x4.y) + bfhi(e4.y) * r2s * q0[3];
                o1[0] = bflo(x4.z) + bflo(e4.z) * r2s * q1[0]; o1[1] = bfhi(x4.z) + bfhi(e4.z) * r2s * q1[1];
                o1[2] = bflo(x4.w) + bflo(e4.w) * r2s * q1[2]; o1[3] = bfhi(x4.w) + bfhi(e4.w) * r2s * q1[3];
                *(f32x4*)(p.out + grow * D + c) = o0; *(f32x4*)(p.out + grow * D + c + 4) = o1;
            }
    }
}

#define XB_TMO      128
#define XB_XCNT(j)  (256  + 64 * (j))
#define XB_XSUB(j)  (1280 + 64 * (j))
#define XB_XGEN(j)  (2304 + 64 * (j))
#define XB_TOP      3328
#define XB_TOPGEN   3392
#define XCD_BAR_WORDS 3456
#define XB_SPIN_CAP (1u << 18)
DI unsigned xb_ld(unsigned* p)              { return __hip_atomic_load(p, __ATOMIC_RELAXED, __HIP_MEMORY_SCOPE_AGENT); }
DI unsigned xb_add(unsigned* p, unsigned v) { return __hip_atomic_fetch_add(p, v, __ATOMIC_RELAXED, __HIP_MEMORY_SCOPE_AGENT); }
DI unsigned xb_xcc_id() { return (unsigned)__builtin_amdgcn_s_getreg((3 << 11) | 20) & 0xFu; }
#define XB_SPIN(cond, bar) do { unsigned _sp = 0; while (cond) { __builtin_amdgcn_s_sleep(1); \
    if ((++_sp & 255u) == 0u) { if (xb_ld(&(bar)[XB_TMO])) break; if (_sp > XB_SPIN_CAP) { atomicAdd(&(bar)[XB_TMO], 1u); break; } } } } while (0)
struct XcdBarrier { unsigned* bar; unsigned x; volatile LAS unsigned* st; int wv; };
DI XcdBarrier xcd_barrier_post(unsigned* bar, volatile LAS unsigned* st, int wv) {
    XcdBarrier b; b.bar = bar; b.x = xb_xcc_id(); b.st = st; b.wv = wv;
    if (otid(wv) == 0) (void)xb_add(&bar[XB_XCNT(b.x)], 1u);
    return b;
}
DI void xcd_barrier_complete(unsigned* bar, unsigned x, unsigned& nloc, unsigned& nx) {
    const unsigned G = gridDim.x * gridDim.y * gridDim.z;
    unsigned sum, cnt, mine, sp = 0u;
    for (;;) {
        sum = 0u; cnt = 0u; mine = 0u;
#pragma unroll
        for (unsigned j = 0; j < 16; ++j) { const unsigned c = xb_ld(&bar[XB_XCNT(j)]); sum += c; cnt += (c > 0u) ? 1u : 0u; mine = (j == x) ? c : mine; }
        if (sum == G) break;
        __builtin_amdgcn_s_sleep(1);
        if ((++sp & 255u) == 0u) { if (xb_ld(&bar[XB_TMO])) break; if (sp > XB_SPIN_CAP) { atomicAdd(&bar[XB_TMO], 1u); break; } }
    }
    nloc = mine > 0u ? mine : 1u; nx = cnt > 0u ? cnt : 1u;
}
DI void xcd_barrier(const XcdBarrier& b) {
    asm volatile("s_waitcnt vmcnt(0)" ::: "memory");
    __syncthreads();
    if (otid(b.wv) == 0) {
        unsigned* bar = b.bar;
        __builtin_amdgcn_s_waitcnt(0);
        unsigned nloc = b.st[0], nx = b.st[1];
        if (nloc == 0u) { xcd_barrier_complete(bar, b.x, nloc, nx); b.st[0] = nloc; b.st[1] = nx; }
        const unsigned old = xb_add(&bar[XB_XSUB(b.x)], 1u);
        const unsigned gen = old / nloc;
        if (old + 1u == (gen + 1u) * nloc) {
            __builtin_amdgcn_fence(__ATOMIC_RELEASE, "agent");
            asm volatile("s_waitcnt vmcnt(0)" ::: "memory");
            const unsigned og = xb_add(&bar[XB_TOP], 1u);
            const unsigned tg = og / nx;
            if (og + 1u == (tg + 1u) * nx) xb_add(&bar[XB_TOPGEN], 1u);
            else XB_SPIN(xb_ld(&bar[XB_TOPGEN]) == tg, bar);
            __builtin_amdgcn_fence(__ATOMIC_ACQUIRE, "agent");
            xb_add(&bar[XB_XGEN(b.x)], 1u);
            asm volatile("s_waitcnt vmcnt(0)" ::: "memory");
        } else {
            XB_SPIN(xb_ld(&bar[XB_XGEN(b.x)]) == gen, bar);
            __builtin_amdgcn_fence(__ATOMIC_ACQUIRE, "agent");
            asm volatile("s_waitcnt vmcnt(0)" ::: "memory");
        }
    }
    __syncthreads();
}

#ifndef REP_P1
#define REP_P1 1
#endif
#ifndef REP_HG
#define REP_HG 1
#endif
#ifndef REP_GM
#define REP_GM 1
#endif
#ifndef REP_SYNC
#define REP_SYNC 1
#endif
#define GSYNC() do { _Pragma("unroll 1") for (int _r = 0; _r < REP_SYNC; ++_r) xcd_barrier(xbar); } while (0)
__global__ void __launch_bounds__(NTHREADS, 2) fwd_megakernel(Params p) {
    extern __shared__ __attribute__((aligned(16))) unsigned char lds_raw[];
    LAS unsigned char* lds = (LAS unsigned char*)lds_raw;
    cg::grid_group grid = cg::this_grid();
    unsigned char* ws = p.ws;
    const int G = gridDim.x, c = blockIdx.x;
    const int wv = __builtin_amdgcn_readfirstlane((int)threadIdx.x >> 6);
    if (threadIdx.x < 16) ((LAS unsigned*)(lds + LDS_MISC))[threadIdx.x] = 0u;
    __syncthreads();
    const XcdBarrier xbar = xcd_barrier_post((unsigned*)(ws + WS_BAR), (volatile LAS unsigned*)(lds + LDS_MISC), wv);

    phase0(wv, p, lds);
    if (gridDim.y == 0xFFFFu) grid.sync();
    GSYNC();
    {
        pg::Order S; S.init(M_TOT, 3 * D, G, c, 1);
        SrcIn P; P.A = (const char*)(ws + WS_H); P.Bt = (const char*)(ws + WS_WIN) + (size_t)3 * D * D * 2; P.split_pn = 1 << 30; P.jump_rows = 0;
        EpiScanT E; E.base = (bf16_t*)(ws + WS_Q); E.seg_stride = U / 2; E.lb = (const float*)(ws + WS_LB);
        pg::gemm_phase<true>(wv, lds, D, S, P, E);
    }
    {
        pg::Order S; S.init(M_TOT, D, G, c, 1);
        SrcIn P; P.A = (const char*)(ws + WS_H); P.Bt = (const char*)(ws + WS_WIN) + (size_t)6 * D * D * 2; P.split_pn = 1 << 30; P.jump_rows = 0;
        EpiSilu E; E.outp = (bf16_t*)(ws + WS_ZB);
        pg::gemm_phase(wv, lds, D, S, P, E);
    }
    GSYNC();
#pragma unroll 1
    for (int rep = 0; rep < REP_HG; ++rep)
    for (int it = c; it < BATCH * 8; it += G) {
        const int b = it >> 3, hd = it & 7;
        const size_t ib0 = (size_t)it * 64 * 4096;
        hgrn_item(wv, lds, (const bf16_t*)(ws + WS_Q) + ib0, (const bf16_t*)(ws + WS_LF) + ib0, (const bf16_t*)(ws + WS_INP) + ib0, (const bf16_t*)(ws + WS_ZB), (bf16_t*)(ws + WS_GB), p.hnorm_g + hd * 128, (size_t)b * SEQ * D + hd * 128);
    }
    GSYNC();
    for (int sl = 0; sl < NSLICE; ++sl) {
        bf16_t* GU = (bf16_t*)(ws + SL(0)); bf16_t* GV = (bf16_t*)(ws + SL(1)); bf16_t* SZA = (bf16_t*)(ws + SL(2));
        bf16_t* SGA = (bf16_t*)(ws + SL(3)); bf16_t* SGB = (bf16_t*)(ws + SL(4)); bf16_t* EE = (bf16_t*)(ws + SL(5));
        bf16_t* MRG = GV; bf16_t* TT = SZA; bf16_t* X1B = GU; bf16_t* EG = SGB; bf16_t* GA = (bf16_t*)(ws + WS_GA);
        {
            pg::Order S; S.init(MS, 5 * D, G, c, 1);
            SrcOther P; P.A = (const char*)(ws + WS_H) + (size_t)sl * HU; P.Bt = (const char*)(ws + WS_WIN);
            EpiOther E; E.guz = GU; E.gv = GV; E.sg = SGA; E.lnp = (f32x2*)(ws + WS_LNP);
            pg::gemm_phase(wv, lds, D, S, P, E);
        }
        GSYNC();
#pragma unroll 1
        for (int rep = 0; rep < REP_GM; ++rep)
        for (int it = c; it < (MS / 128) * 4; it += G) gmlp_item(wv, lds, p, GU, GV, (const f32x2*)(ws + WS_LNP), GA, it >> 2, it & 3);
        GSYNC();
        {
            pg::Order S; S.init(MS, D, G, c, 2);
            SrcMerge P; P.A0 = (const char*)GA; P.A1 = (const char*)(ws + WS_GB) + (size_t)sl * HU; P.B0 = (const char*)(ws + WS_WA); P.B1 = (const char*)(ws + WS_WB);
            EpiMerge E; E.sg = SGA; E.outp = MRG;
            pg::gemm_phase(wv, lds, D, S, P, E);
        }
        GSYNC();
        {
            pg::Order S; S.init(MS, D, G, c, 1);
            SrcPlain P; P.A = (const char*)MRG; P.Bt = (const char*)(ws + WS_WO); P.K = D;
            EpiX1 E; E.x = p.x; E.g_post = p.g_post; E.x1b = X1B; E.xs = (float*)(ws + WS_XS); E.cnt = (unsigned*)(ws + WS_CNT) + (size_t)(0 * NSLICE + sl) * (MS / 256) * 16; E.lds = lds; E.row_off = (size_t)sl * MS;
            pg::gemm_phase(wv, lds, D, S, P, E);
        }
        {
            pg::Order S; S.init(MS, D, G, c, 1);
            SrcPlain P; P.A = (const char*)(ws + WS_PBF) + (size_t)sl * MS * PLE * 2; P.Bt = (const char*)(ws + WS_WP); P.K = PLE;
            EpiRow<1> E; E.outp = EE; E.ssq = nullptr; E.e = nullptr; E.bias = nullptr;
            pg::gemm_phase(wv, lds, PLE, S, P, E);
        }
        GSYNC();
        {
            pg::Order S; S.init(MS, D, G, c, 1);
            SrcPlain P; P.A = (const char*)X1B; P.Bt = (const char*)(ws + WS_WG); P.K = D;
            EpiOut E; E.e = EE; E.bias = p.b_gate; E.x1b = X1B; E.g_ple = p.g_ple; E.out = p.out; E.xs = (float*)(ws + WS_XS) + (size_t)MS * 4;
            E.cnt = (unsigned*)(ws + WS_CNT) + (size_t)(1 * NSLICE + sl) * (MS / 256) * 16; E.lds = lds; E.row_off = (size_t)sl * MS;
            pg::gemm_phase(wv, lds, D, S, P, E);
        }
        if (sl + 1 < NSLICE) GSYNC();
    }
}

extern "C" void kernel_launch(void* const* d_in, const int* in_sizes, int n_in, void* d_out, int out_size, void* d_ws, size_t ws_size, hipStream_t stream) {
    static int grid_blocks = 0;
    if (grid_blocks == 0) {
        if (ws_size < WS_END) { fprintf(stderr, "kernel_launch: workspace too small: %zu < %zu\n", ws_size, (size_t)WS_END); grid_blocks = -1; return; }
        int dev = 0, cus = 0, per_cu = 0;
        hipGetDevice(&dev);
        hipDeviceGetAttribute(&cus, hipDeviceAttributeMultiprocessorCount, dev);
        hipFuncSetAttribute((const void*)fwd_megakernel, hipFuncAttributeMaxDynamicSharedMemorySize, LDS_BYTES);
        hipOccupancyMaxActiveBlocksPerMultiprocessor(&per_cu, (const void*)fwd_megakernel, NTHREADS, LDS_BYTES);
        if (per_cu < 1) { fprintf(stderr, "kernel_launch: occupancy query returned %d\n", per_cu); per_cu = 1; }
        (void)hipGetLastError();
        grid_blocks = cus * 1;
    }
    if (grid_blocks < 0) return;
    Params p{};
    p.x = (const float*)d_in[0]; p.p = (const float*)d_in[1]; p.w_in = (const float*)d_in[2]; p.ln_g = (const float*)d_in[3]; p.ln_b = (const float*)d_in[4];
    p.w_s = (const float*)d_in[5]; p.b_s = (const float*)d_in[6]; p.lb_logits = (const float*)d_in[7]; p.hnorm_g = (const float*)d_in[8];
    p.w_a = (const float*)d_in[9]; p.w_b = (const float*)d_in[10]; p.w_out = (const float*)d_in[11]; p.g_pre = (const float*)d_in[12]; p.g_post = (const float*)d_in[13];
    p.w_ple = (const float*)d_in[14]; p.w_gate = (const float*)d_in[15]; p.b_gate = (const float*)d_in[16]; p.g_ple = (const float*)d_in[17];
    p.out = (float*)d_out; p.ws = (unsigned char*)d_ws;
    if (hipMemsetAsync((char*)d_ws + WS_BAR, 0, 16384 + WS_CNT_BYTES, stream) != hipSuccess) { fprintf(stderr, "memset of barrier words failed\n"); return; }
    void* args[] = {&p};
    hipError_t e = hipLaunchCooperativeKernel((const void*)fwd_megakernel, dim3(grid_blocks), dim3(NTHREADS), args, LDS_BYTES, stream);
    if (e != hipSuccess) fprintf(stderr, "cooperative launch failed: %s (grid %d)\n", hipGetErrorString(e), grid_blocks);
}
```
